# Optimizing an MI355X kernel written in HIP

```python
import numpy as np
import jax, jax.numpy as jnp
from jax import lax

D_MODEL = 1024
BATCH = 8
SEQ = 2048
DEPTH = 4
DEC_BATCH = 2
DEC_SEQ = 16384
PAST_LEN = 128

D_MIX = D_MODEL
N_MIXERS = 4
D_BRANCH = D_MIX // N_MIXERS
N_GROUPS = 4
D_GROUP = D_BRANCH // N_GROUPS
POOL_WINDOWS = (2, 4, 8, 16)
CHUNK = 128
GRID_W = 64
NA_KH_MAX = 8
NA_KW = 16
N_IN_SLICES = 11
D_IN = N_IN_SLICES * D_BRANCH
RMS_EPS = 1e-6
LN_EPS = 1e-5

kernel_name = "hybrid_parallel_group_encoder"


def rmsnorm(x, g):
    xf = x.astype(jnp.float32)
    y = xf * lax.rsqrt(jnp.mean(xf * xf, axis=-1, keepdims=True) + RMS_EPS)
    return (y * g.astype(jnp.float32)).astype(x.dtype)


def pool_mixer(a, w_pool, pool_scale):
    B, L, _ = a.shape
    ag = a.astype(jnp.float32).reshape(B, L, N_GROUPS, D_GROUP)
    cs = jnp.concatenate([jnp.zeros((B, 1, N_GROUPS, D_GROUP), jnp.float32),
                          lax.cumsum(ag, axis=1)], axis=1)
    t = np.arange(L)
    outs = []
    for g, w in enumerate(POOL_WINDOWS):
        lo = np.clip(t - w // 2, 0, L)
        hi = np.clip(t - w // 2 + w, 0, L)
        cnt = (hi - lo).astype(np.float32)[None, :, None]
        cs_g = cs[:, :, g]
        mean = (jnp.take(cs_g, hi, axis=1) - jnp.take(cs_g, lo, axis=1)) / cnt
        outs.append(mean - ag[:, :, g])
    p = jnp.stack(outs, axis=2)
    y = jnp.einsum('blgc,gcd->blgd', p, w_pool.astype(jnp.float32))
    y = y.reshape(B, L, D_BRANCH) * pool_scale.astype(jnp.float32)
    return y.astype(a.dtype)


def sgu_mixer(u, v, sgu_norm_g, sgu_w, sgu_b):
    B, L, _ = u.shape
    u = jax.nn.gelu(u)
    vf = jax.nn.gelu(v).astype(jnp.float32)
    mu = jnp.mean(vf, axis=-1, keepdims=True)
    var = jnp.mean((vf - mu) ** 2, axis=-1, keepdims=True)
    vn = (vf - mu) * lax.rsqrt(var + LN_EPS) * sgu_norm_g.astype(jnp.float32)
    vc = vn.reshape(B, L // CHUNK, CHUNK, N_GROUPS, D_GROUP)
    s = jnp.einsum('hpq,bnqhc->bnphc', sgu_w.astype(jnp.float32), vc)
    s = s + sgu_b.astype(jnp.float32).T[:, :, None]
    return (u.astype(jnp.float32) * s.reshape(B, L, D_BRANCH)).astype(u.dtype)


def fourier_mixer(f, fnet_w):
    B, L, _ = f.shape
    ff = f.astype(jnp.float32).reshape(B, L, N_GROUPS, D_GROUP)
    z = jnp.fft.fft2(ff, axes=(1, 3), norm='ortho').real
    y = jnp.einsum('blgc,gcd->blgd', z, fnet_w.astype(jnp.float32))
    return y.reshape(B, L, D_BRANCH).astype(f.dtype)


def na_mixer(q, k, v, na_rpb):
    B, L, _ = q.shape
    rows = L // GRID_W
    kh = min(NA_KH_MAX, rows)
    scale = D_GROUP ** -0.5
    qg = q.reshape(B, rows, GRID_W, N_GROUPS, D_GROUP)
    kg = k.reshape(B, rows, GRID_W, N_GROUPS, D_GROUP)
    vg = v.reshape(B, rows, GRID_W, N_GROUPS, D_GROUP)
    r = np.arange(rows)
    rs = np.clip(r - kh // 2, 0, rows - kh)
    c = np.arange(GRID_W)
    cst = np.clip(c - NA_KW // 2, 0, GRID_W - NA_KW)
    col_idx = cst[:, None] + np.arange(NA_KW)[None, :]
    dc = col_idx - c[:, None]
    rpb_c = na_rpb[:, :, dc + NA_KW - 1]

    def row_block(args):
        q_row, r_i, rs_i = args
        k_rows = lax.dynamic_slice_in_dim(kg, rs_i, kh, axis=1)
        v_rows = lax.dynamic_slice_in_dim(vg, rs_i, kh, axis=1)
        k_sel = k_rows[:, :, col_idx]
        v_sel = v_rows[:, :, col_idx]
        dr = rs_i + jnp.arange(kh) - r_i
        bias = rpb_c[:, dr + NA_KH_MAX - 1]
        bias = jnp.transpose(bias, (0, 2, 1, 3))[None].astype(jnp.float32)
        s = jnp.einsum('bqhd,bkqwhd->bhqkw', q_row, k_sel,
                       preferred_element_type=jnp.float32) * scale + bias
        p = jax.nn.softmax(s.reshape(B, N_GROUPS, GRID_W, kh * NA_KW), axis=-1)
        p = p.reshape(B, N_GROUPS, GRID_W, kh, NA_KW).astype(v.dtype)
        return jnp.einsum('bhqkw,bkqwhd->bqhd', p, v_sel)

    out = lax.map(row_block, (jnp.moveaxis(qg, 1, 0),
                              jnp.asarray(r, jnp.int32), jnp.asarray(rs, jnp.int32)))
    return jnp.moveaxis(out, 0, 1).reshape(B, L, D_BRANCH)


def mixer_layer(x, c, norm_g, w_ada, b_ada, w_in, w_out, pool_w, pool_scale,
                sgu_norm_g, sgu_w, sgu_b, fnet_w, na_rpb):
    mod = jax.nn.silu(c) @ w_ada + b_ada
    shift, scl, gate = jnp.split(mod, 3, axis=-1)
    h = rmsnorm(x, norm_g) * (1.0 + scl[:, None]) + shift[:, None]
    z = h @ w_in
    (a_in, a_gate, b_u, b_v, b_gate, c_in, c_gate,
     d_q, d_k, d_v, d_gate) = jnp.split(z, N_IN_SLICES, axis=-1)
    ya = pool_mixer(a_in, pool_w, pool_scale) * jax.nn.silu(a_gate)
    yb = sgu_mixer(b_u, b_v, sgu_norm_g, sgu_w, sgu_b) * jax.nn.silu(b_gate)
    yc = fourier_mixer(c_in, fnet_w) * jax.nn.silu(c_gate)
    yd = na_mixer(d_q, d_k, d_v, na_rpb) * jax.nn.silu(d_gate)
    y = jnp.concatenate([ya, yb, yc, yd], axis=-1) @ w_out
    return x + gate[:, None] * y


def trunk(x, c, norm_g, w_ada, b_ada, w_in, w_out, pool_w, pool_scale,
          sgu_norm_g, sgu_w, sgu_b, fnet_w, na_rpb, final_norm_g):
    for l in range(DEPTH):
        x = mixer_layer(x, c, norm_g[l], w_ada[l], b_ada[l], w_in[l], w_out[l],
                        pool_w[l], pool_scale[l], sgu_norm_g[l], sgu_w[l], sgu_b[l],
                        fnet_w[l], na_rpb[l])
    return rmsnorm(x, final_norm_g)


def setup_inputs(seed: int = 0) -> dict:
    key = jax.random.key(seed)
    ks = jax.random.split(key, 17)
    f32 = jnp.float32
    n = lambda k, s: jax.random.normal(k, s, f32)
    return {
        "x_prompt": n(ks[0], (BATCH, SEQ, D_MODEL)),
        "x_sample": n(ks[1], (DEC_BATCH, DEC_SEQ, D_MODEL)),
        "c_prompt": n(ks[2], (BATCH, D_MODEL)),
        "c_sample": n(ks[3], (DEC_BATCH, D_MODEL)),
        "norm_g": 1.0 + 0.02 * n(ks[4], (DEPTH, D_MODEL)),
        "w_ada": n(ks[5], (DEPTH, D_MODEL, 3 * D_MODEL)) * (0.5 * D_MODEL ** -0.5),
        "b_ada": 0.02 * n(ks[6], (DEPTH, 3 * D_MODEL)),
        "w_in": n(ks[7], (DEPTH, D_MODEL, D_IN)) * D_MODEL ** -0.5,
        "w_out": n(ks[8], (DEPTH, D_MIX, D_MODEL)) * D_MIX ** -0.5,
        "pool_w": n(ks[9], (DEPTH, N_GROUPS, D_GROUP, D_GROUP)) * D_GROUP ** -0.5,
        "pool_scale": 1.0 + 0.02 * n(ks[10], (DEPTH, D_BRANCH)),
        "sgu_norm_g": 1.0 + 0.02 * n(ks[11], (DEPTH, D_BRANCH)),
        "sgu_w": n(ks[12], (DEPTH, N_GROUPS, CHUNK, CHUNK)) * CHUNK ** -0.5,
        "sgu_b": 1.0 + 0.02 * n(ks[13], (DEPTH, N_GROUPS, CHUNK)),
        "fnet_w": n(ks[14], (DEPTH, N_GROUPS, D_GROUP, D_GROUP)) * D_GROUP ** -0.5,
        "na_rpb": 0.1 * n(ks[15], (DEPTH, N_GROUPS, 2 * NA_KH_MAX - 1, 2 * NA_KW - 1)),
        "final_norm_g": 1.0 + 0.02 * n(ks[16], (D_MODEL,)),
    }


def reference(x_prompt, x_sample, c_prompt, c_sample, norm_g, w_ada, b_ada, w_in, w_out,
              pool_w, pool_scale, sgu_norm_g, sgu_w, sgu_b, fnet_w, na_rpb, final_norm_g):
    y_prompt = trunk(x_prompt, c_prompt, norm_g, w_ada, b_ada, w_in, w_out, pool_w, pool_scale,
                     sgu_norm_g, sgu_w, sgu_b, fnet_w, na_rpb, final_norm_g)
    y_sample = trunk(x_sample, c_sample, norm_g, w_ada, b_ada, w_in, w_out, pool_w, pool_scale,
                     sgu_norm_g, sgu_w, sgu_b, fnet_w, na_rpb, final_norm_g)
    return (y_prompt, y_sample)
```

```cpp
#include <hip/hip_runtime.h>
#include <hip/hip_cooperative_groups.h>
#include <cstdio>
#include <cstdint>
namespace cg = cooperative_groups;
namespace pg8 {
#define PG8_LAS __attribute__((address_space(3)))
typedef unsigned short bf16_t;
typedef short bf16x8 __attribute__((ext_vector_type(8)));
typedef float f32x4 __attribute__((ext_vector_type(4)));
typedef unsigned u32x4 __attribute__((ext_vector_type(4)));
constexpr int BM = 256, BK = 64, HALF = 128, HTB = HALF * BK * 2  , STAGE_BYTES = 8 * HTB, NXCD = 8, WGM = 8;

__host__ __device__ __forceinline__ int lds_byte(int r, int c) { const int st = (r >> 4) * 2 + (c >> 5), rr = r & 15, cc = c & 31, ob = rr * 64 + cc * 2; return st * 1024 + (ob ^ (((ob >> 9) & 1) << 5)); }
__host__ __device__ __forceinline__ void stage_rc(int b, int& R, int& C) { const int st = b / 1024, sb = b % 1024, swz = sb ^ (((sb >> 9) & 1) << 5); R = (st >> 1) * 16 + swz / 64; C = (st & 1) * 32 + (swz % 64) / 2; }
__host__ __device__ __forceinline__ int perm32(int rho) { const int n = rho >> 4, i = rho & 15; return 8 * (i >> 2) + 4 * n + (i & 3); }

struct Unit { int pm, pn; };
struct Gemm { const bf16_t* A; const bf16_t* Bt; int M, N, K, ldA, ldB; unsigned tmask; size_t bstride; };
__device__ __forceinline__ void unit_ptrs(const Gemm& g, const Unit& u, size_t tsA, size_t tsB, const char*& a, const char*& b) {
    const int bt = u.pm < 64 ? (u.pm >> 3) : 8 + ((u.pm - 64) >> 6);
    const char* w = (const char*)g.Bt + (size_t)bt * g.bstride + (size_t)u.pn * tsB;
    if ((g.tmask >> u.pn) & 1u) { a = w; b = (const char*)g.A + (size_t)u.pm * tsA; }
    else { a = (const char*)g.A + (size_t)u.pm * tsA; b = w; }
}
typedef _Float16 f16x8_t __attribute__((ext_vector_type(8)));
template <bool F16> __device__ __forceinline__ f32x4 mma16(bf16x8 a, bf16x8 b, f32x4 c) {
    if constexpr (F16) return __builtin_amdgcn_mfma_f32_16x16x32_f16(__builtin_bit_cast(f16x8_t, a), __builtin_bit_cast(f16x8_t, b), c, 0, 0, 0);
    else return __builtin_amdgcn_mfma_f32_16x16x32_bf16(a, b, c, 0, 0, 0);
}

struct StaticOrder {
    int nM, nN, nwg, G, c;
    __host__ __device__ void init(int M, int N, int G_, int c_) { nM = M / BM; nN = N / BM; nwg = nM * nN; G = G_; c = c_; }
    __host__ __device__ bool next(int i, Unit& u) const {
        const long L = (long)i * G + c; if (L >= nwg) return false;
        int wgid = (int)L; { const int q = nwg / NXCD, r = nwg % NXCD, xcd = wgid % NXCD, off = wgid / NXCD; wgid = (xcd < r ? xcd * (q + 1) : r * (q + 1) + (xcd - r) * q) + off; }
        const int nig = WGM * nN, gid = wgid / nig, fm = gid * WGM, gsz = (nM - fm) < WGM ? (nM - fm) : WGM;
        u.pm = fm + ((wgid % nig) % gsz); u.pn = (wgid % nig) / gsz; return true;
    }
    __device__ __forceinline__ void a_ready(const Unit&) const {}
    __device__ __forceinline__ void done(const Unit&) const {}
};
typedef float f32x2_t __attribute__((ext_vector_type(2))); typedef __bf16 bf16x2_t __attribute__((ext_vector_type(2)));
__device__ __forceinline__ unsigned cvt_pk_bf16(float lo, float hi) { f32x2_t v = {lo, hi}; bf16x2_t b = __builtin_convertvector(v, bf16x2_t); return __builtin_bit_cast(unsigned, b); }

template <class Epi, class Sched, bool ALIGN_EPI = false, bool SP2 = false, bool F16 = false>
__device__ __forceinline__ void gemm_phase(PG8_LAS unsigned char* lds, const Gemm g, const Sched& S, const Epi& E) {
    int tid = threadIdx.x; asm volatile("" : "+v"(tid));
    const int wid = __builtin_amdgcn_readfirstlane(tid >> 6), lane = tid & 63, wr = wid >> 2, wc = wid & 3, fr = lane & 15, fq = lane >> 4;
    const int K = g.K, nt = K / BK;
    unsigned voffA[2], voffB[2];
#pragma unroll
    for (int i = 0; i < 2; ++i) { int R, C; stage_rc(tid * 16 + i * 8192, R, C); const int Rb = Epi::PERM ? ((R & ~31) + perm32(R & 31)) : R;
        voffA[i] = (unsigned)(R * g.ldA + C) * 2u; voffB[i] = (unsigned)(Rb * g.ldB + C) * 2u; }
    const size_t kstep = (size_t)(BK * 2);
    const size_t hsA = (size_t)HALF * g.ldA * 2, hsB = (size_t)HALF * g.ldB * 2;
    const size_t tsA = 2 * hsA, tsB = 2 * hsB;
    const unsigned ldsw = (unsigned)wid * 1024u;
    const int aoff = lds_byte(wr * 64 + fr, fq * 8), boff = lds_byte(wc * 32 + fr, fq * 8);
#define PG8_SA(b, h) (((b) * 2 + (h)) * HTB)
#define PG8_SB(b, h) ((4 + (b) * 2 + (h)) * HTB)
#define PG8_STAGE(bufoff, gbase, voff) do { _Pragma("unroll") for (int _i = 0; _i < 2; ++_i) \
        __builtin_amdgcn_global_load_lds((const unsigned*)((const char*)(gbase) + (voff)[_i]), (PG8_LAS unsigned*)(lds + (bufoff) + ldsw + _i * 8192), 16, 0, 0); } while (0)
#define PG8_LDA(dst, b, h) do { _Pragma("unroll") for (int m = 0; m < 4; ++m) _Pragma("unroll") for (int k = 0; k < 2; ++k) dst[m][k] = *(const PG8_LAS bf16x8*)(lds + PG8_SA(b, h) + aoff + m * 2048 + k * 1024); } while (0)
#define PG8_LDB(dst, b, h) do { _Pragma("unroll") for (int n = 0; n < 2; ++n) _Pragma("unroll") for (int k = 0; k < 2; ++k) dst[n][k] = *(const PG8_LAS bf16x8*)(lds + PG8_SB(b, h) + boff + n * 2048 + k * 1024); } while (0)
#define PG8_MMA(ai, bj, At, Bt) do { __builtin_amdgcn_s_setprio(1); _Pragma("unroll") for (int m = 0; m < 4; ++m) _Pragma("unroll") for (int n = 0; n < 2; ++n) _Pragma("unroll") for (int k = 0; k < 2; ++k) \
        acc[ai][bj][m][n] = mma16<F16>(Bt[n][k], At[m][k], acc[ai][bj][m][n]); __builtin_amdgcn_s_setprio(0); } while (0)
#define PG8_WAIT_V(n) asm volatile("s_waitcnt vmcnt(" #n ")" ::: "memory")
#define PG8_WAIT_L(n) asm volatile("s_waitcnt lgkmcnt(" #n ")" ::: "memory")
#define PG8_BAR __builtin_amdgcn_s_barrier()
#define PG8_SCHED __builtin_amdgcn_sched_barrier(0)
    Unit cur, nxt; int ui = 0;
    typename Epi::Pre pre;
    if (!S.next(0, cur)) return;
    f32x4 acc[2][2][4][2];
#pragma unroll
    for (int a = 0; a < 2; ++a)
#pragma unroll
        for (int b = 0; b < 2; ++b)
#pragma unroll
            for (int m = 0; m < 4; ++m)
#pragma unroll
                for (int n = 0; n < 2; ++n) acc[a][b][m][n] = (f32x4){0.f, 0.f, 0.f, 0.f};
    bf16x8 At[4][2], B0[2][2], B1[2][2];
    const char* cA; const char* cB; unit_ptrs(g, cur, tsA, tsB, cA, cB);
    S.a_ready(cur);
    if constexpr (SP2) {
        PG8_STAGE(PG8_SB(0, 0), cB, voffB); PG8_STAGE(PG8_SB(0, 1), cB + hsB, voffB); PG8_STAGE(PG8_SA(0, 0), cA, voffA); PG8_STAGE(PG8_SA(0, 1), cA + hsA, voffA);
        if (wr == 1) PG8_BAR;
        PG8_WAIT_V(2); PG8_BAR;
        PG8_STAGE(PG8_SB(1, 0), cB + kstep, voffB); PG8_STAGE(PG8_SA(1, 0), cA + kstep, voffA); PG8_STAGE(PG8_SB(1, 1), cB + hsB + kstep, voffB);
        PG8_WAIT_V(6); PG8_BAR;
    } else {
        PG8_STAGE(PG8_SB(0, 0), cB, voffB); PG8_STAGE(PG8_SA(0, 0), cA, voffA); PG8_STAGE(PG8_SB(0, 1), cB + hsB, voffB); PG8_STAGE(PG8_SA(0, 1), cA + hsA, voffA);
        if (wr == 1) PG8_BAR;
        PG8_WAIT_V(4); PG8_BAR;
        PG8_STAGE(PG8_SB(1, 0), cB + kstep, voffB); PG8_STAGE(PG8_SA(1, 0), cA + kstep, voffA); PG8_STAGE(PG8_SB(1, 1), cB + hsB + kstep, voffB);
        PG8_WAIT_V(6); PG8_BAR;
    }
    for (;;) {
        const bool has_next = S.next(ui + 1, nxt);
        const char* nA = cA; const char* nB = cB; if (has_next) unit_ptrs(g, nxt, tsA, tsB, nA, nB);
        for (int t = 0; t < nt; t += 2) {
            const bool last = (t == nt - 2);
            const char* a1 = cA + (size_t)(t + 1) * kstep;
            const char* a2 = last ? nA : cA + (size_t)(t + 2) * kstep; const char* b2 = last ? nB : cB + (size_t)(t + 2) * kstep;
            const char* a3 = a2 + kstep; const char* b3 = b2 + kstep;
            if (last && has_next) S.a_ready(nxt);
            if (last) E.prefetch(pre, cur, wr, wc, fr, fq);
            if constexpr (SP2) {
            PG8_LDB(B0, 0, 0); PG8_LDB(B1, 0, 1); PG8_SCHED; PG8_LDA(At, 0, 0); PG8_STAGE(PG8_SA(1, 1), a1 + hsA, voffA);
            PG8_WAIT_V(8); PG8_WAIT_L(0); PG8_BAR; PG8_MMA(0, 0, At, B0); PG8_MMA(0, 1, At, B1); PG8_BAR; PG8_SCHED;
            PG8_LDA(At, 0, 1); PG8_STAGE(PG8_SB(0, 0), b2, voffB); PG8_STAGE(PG8_SB(0, 1), b2 + hsB, voffB); PG8_STAGE(PG8_SA(0, 0), a2, voffA);
            PG8_WAIT_V(8); PG8_WAIT_L(0); PG8_BAR; PG8_MMA(1, 0, At, B0); PG8_MMA(1, 1, At, B1); PG8_BAR; PG8_SCHED;
            PG8_LDB(B0, 1, 0); PG8_LDB(B1, 1, 1); PG8_SCHED; PG8_LDA(At, 1, 0); PG8_STAGE(PG8_SA(0, 1), a2 + hsA, voffA);
            PG8_WAIT_V(8); PG8_WAIT_L(0); PG8_BAR; PG8_MMA(0, 0, At, B0); PG8_MMA(0, 1, At, B1); PG8_BAR; PG8_SCHED;
            PG8_LDA(At, 1, 1); PG8_STAGE(PG8_SB(1, 0), b3, voffB); PG8_STAGE(PG8_SB(1, 1), b3 + hsB, voffB); PG8_STAGE(PG8_SA(1, 0), a3, voffA);
            PG8_WAIT_V(8); PG8_WAIT_L(0); PG8_BAR; PG8_MMA(1, 0, At, B0); PG8_MMA(1, 1, At, B1); PG8_BAR; PG8_SCHED;
            } else {
            PG8_LDB(B0, 0, 0); PG8_SCHED; PG8_LDA(At, 0, 0); PG8_STAGE(PG8_SA(1, 1), a1 + hsA, voffA);
            PG8_WAIT_L(8); PG8_BAR; PG8_WAIT_L(0); PG8_MMA(0, 0, At, B0); PG8_BAR; PG8_SCHED;
            PG8_LDB(B1, 0, 1); PG8_STAGE(PG8_SB(0, 0), b2, voffB);
            PG8_BAR; PG8_WAIT_L(0); PG8_MMA(0, 1, At, B1); PG8_BAR;
            PG8_LDA(At, 0, 1); PG8_STAGE(PG8_SA(0, 0), a2, voffA);
            PG8_BAR; PG8_WAIT_L(0); PG8_MMA(1, 0, At, B0); PG8_BAR; PG8_SCHED;
            PG8_STAGE(PG8_SB(0, 1), b2 + hsB, voffB);
            PG8_WAIT_V(6); PG8_BAR; PG8_MMA(1, 1, At, B1); PG8_BAR;
            PG8_LDB(B0, 1, 0); PG8_SCHED; PG8_LDA(At, 1, 0); PG8_STAGE(PG8_SA(0, 1), a2 + hsA, voffA);
            PG8_WAIT_L(8); PG8_BAR; PG8_WAIT_L(0); PG8_MMA(0, 0, At, B0); PG8_BAR; PG8_SCHED;
            PG8_LDB(B1, 1, 1); PG8_STAGE(PG8_SB(1, 0), b3, voffB);
            PG8_BAR; PG8_WAIT_L(0); PG8_MMA(0, 1, At, B1); PG8_BAR;
            PG8_LDA(At, 1, 1); PG8_STAGE(PG8_SA(1, 0), a3, voffA);
            PG8_BAR; PG8_WAIT_L(0); PG8_MMA(1, 0, At, B0); PG8_BAR; PG8_SCHED;
            PG8_STAGE(PG8_SB(1, 1), b3 + hsB, voffB);
            PG8_WAIT_V(6); PG8_BAR; PG8_MMA(1, 1, At, B1); PG8_BAR;
            }
        }
        if constexpr (ALIGN_EPI) { if (wr == 0) PG8_BAR; }
        if constexpr (!Epi::AFTER_DRAIN) { E(acc, cur, wr, wc, fr, fq, pre); S.done(cur); }
        if (!has_next) break;
#pragma unroll
        for (int a = 0; a < 2; ++a)
#pragma unroll
            for (int b = 0; b < 2; ++b)
#pragma unroll
                for (int m = 0; m < 4; ++m)
#pragma unroll
                    for (int n = 0; n < 2; ++n) acc[a][b][m][n] = (f32x4){0.f, 0.f, 0.f, 0.f};
        cur = nxt; cA = nA; cB = nB; ++ui;
        if constexpr (ALIGN_EPI) { if (wr == 1) PG8_BAR; }
    }
    PG8_WAIT_V(0);
    if constexpr (!ALIGN_EPI) { if (wr == 0) PG8_BAR; }
    PG8_BAR;
    if constexpr (Epi::AFTER_DRAIN) { E.fused(acc, cur, wr, wc, fr, fq, lds, wid, lane); S.done(cur); }
#undef PG8_SA
#undef PG8_SB
#undef PG8_STAGE
#undef PG8_LDA
#undef PG8_LDB
#undef PG8_MMA
#undef PG8_WAIT_V
#undef PG8_WAIT_L
#undef PG8_BAR
#undef PG8_SCHED
}
}

using pg8::bf16_t; using pg8::f32x4; using pg8::u32x4; using pg8::bf16x8; using pg8::cvt_pk_bf16;
#define LAS __attribute__((address_space(3)))
typedef _Float16 f16x8 __attribute__((ext_vector_type(8)));
typedef _Float16 f16x4 __attribute__((ext_vector_type(4)));
typedef _Float16 f16x2 __attribute__((ext_vector_type(2)));
typedef short s16x4 __attribute__((ext_vector_type(4)));
typedef unsigned u32x2 __attribute__((ext_vector_type(2)));
typedef float f32x2 __attribute__((ext_vector_type(2)));
typedef unsigned short u16;

constexpr int D = 1024, MTOK = 49152, NB = 10, NLAYER = 4, ZW = 2304, NIN = 3072, DIN = 2816, NPT = 16384;
constexpr float RMS_EPS = 1e-6f, LN_EPS = 1e-5f;
constexpr int NTHR = 512;
constexpr int LDS_BYTES = 158720;
constexpr int NPHASE = 2 + 4 * NLAYER + 1;

constexpr size_t MiB = 1u << 20;
constexpr size_t WS_WIN = 1 * MiB;
constexpr size_t WS_WOUT = 25 * MiB;
constexpr size_t WS_SGUW = 33 * MiB;
constexpr size_t WS_MOD = 34 * MiB;
constexpr size_t WS_SB = 35 * MiB;
constexpr size_t WS_GM = 36 * MiB;
constexpr size_t WS_SSQ = 37 * MiB;
constexpr size_t WS_DFT = 38 * MiB;
constexpr size_t WS_X16 = 40 * MiB;
constexpr size_t WS_Z = 136 * MiB;
constexpr size_t WS_ZT = 352 * MiB;
constexpr size_t WS_W16 = 424 * MiB;
constexpr size_t WS_END = 484 * MiB;
constexpr size_t DF_C128 = 0, DF_S128 = 32768, DF_NS128 = 65536, DF_T1 = 98304, DF_T2 = 99328, DF_TW16K = 102400, DF_TW2K = 233472;

struct Params { const float* in[17]; float* out; unsigned char* ws; int ph_lo, ph_hi; };

__device__ __forceinline__ int batch_of_tile(int pm) { return pm < 64 ? (pm >> 3) : 8 + ((pm - 64) >> 6); }
__device__ __forceinline__ int batch_of_tok(int t) { return t < NPT ? (t >> 11) : 8 + ((t - NPT) >> 14); }
__device__ __forceinline__ float bf2f(unsigned h) { return __uint_as_float(h << 16); }
__device__ __forceinline__ unsigned f2bf(float f) { unsigned u = __float_as_uint(f); return (u + 0x7fffu + ((u >> 16) & 1u)) >> 16; }
__device__ __forceinline__ float sigm(float x) { return __builtin_amdgcn_rcpf(1.f + __expf(-x)); }
__device__ __forceinline__ float silu_(float v) { return v * sigm(v); }
__device__ __forceinline__ float gelu_(float v) { return v * sigm(1.5957691216f * (v + 0.044715f * v * v * v)); }
__device__ __forceinline__ unsigned pkh(float a, float b) { f16x2 h; h.x = (_Float16)a; h.y = (_Float16)b; return __builtin_bit_cast(unsigned, h); }
__device__ __forceinline__ float wave_sum(float v) {
#pragma unroll
    for (int o = 1; o < 64; o <<= 1) v += __shfl_xor(v, o);
    return v;
}
__device__ __forceinline__ void unpack8(const u32x4 v, float (&f)[8]) {
    f[0] = bf2f(v.x & 0xffffu); f[1] = __uint_as_float(v.x & 0xffff0000u); f[2] = bf2f(v.y & 0xffffu); f[3] = __uint_as_float(v.y & 0xffff0000u);
    f[4] = bf2f(v.z & 0xffffu); f[5] = __uint_as_float(v.z & 0xffff0000u); f[6] = bf2f(v.w & 0xffffu); f[7] = __uint_as_float(v.w & 0xffff0000u);
}
__device__ __forceinline__ float quad_max(float x) {
    auto a = __builtin_amdgcn_permlane16_swap(__float_as_uint(x), __float_as_uint(x), false, false); x = fmaxf(__uint_as_float(a[0]), __uint_as_float(a[1]));
    auto b = __builtin_amdgcn_permlane32_swap(__float_as_uint(x), __float_as_uint(x), false, false); return fmaxf(__uint_as_float(b[0]), __uint_as_float(b[1]));
}
__device__ __forceinline__ float quad_sum(float x) {
    auto a = __builtin_amdgcn_permlane16_swap(__float_as_uint(x), __float_as_uint(x), false, false); x = __uint_as_float(a[0]) + __uint_as_float(a[1]);
    auto b = __builtin_amdgcn_permlane32_swap(__float_as_uint(x), __float_as_uint(x), false, false); return __uint_as_float(b[0]) + __uint_as_float(b[1]);
}
typedef short v4i16_t __attribute__((ext_vector_type(4)));
__device__ __forceinline__ bf16x8 tr_frag(LAS const unsigned char* base, int pitch, int row0, int col0, int lane) {
    const int i16 = lane & 15;
    LAS const unsigned char* p = base + (row0 + (i16 >> 2)) * pitch + (col0 + 4 * (i16 & 3)) * 2;
    const v4i16_t lo = __builtin_amdgcn_ds_read_tr16_b64_v4i16((LAS v4i16_t*)p);
    const v4i16_t hi = __builtin_amdgcn_ds_read_tr16_b64_v4i16((LAS v4i16_t*)(p + 4 * pitch));
    bf16x8 r; r[0] = lo[0]; r[1] = lo[1]; r[2] = lo[2]; r[3] = lo[3]; r[4] = hi[0]; r[5] = hi[1]; r[6] = hi[2]; r[7] = hi[3]; return r;
}
__device__ __forceinline__ f32x4 mma_bf16(bf16x8 a, bf16x8 b, f32x4 c) { return __builtin_amdgcn_mfma_f32_16x16x32_bf16(a, b, c, 0, 0, 0); }
__device__ __forceinline__ f32x4 mma_f16(bf16x8 a, bf16x8 b, f32x4 c) { return __builtin_amdgcn_mfma_f32_16x16x32_f16(__builtin_bit_cast(f16x8, a), __builtin_bit_cast(f16x8, b), c, 0, 0, 0); }

struct Epi1 {
    static constexpr bool PERM = true, AFTER_DRAIN = false;
    bf16_t* Z; u16* ZT; const float* ssq; const float* sb; int noact;
    struct Pre { float v[4]; };
    __device__ __forceinline__ void prefetch(Pre& q, const pg8::Unit& u, int wr, int wc, int fr, int fq) const {
        const int b = batch_of_tile(u.pm);
        if (u.pn < 9) { const int row0 = u.pm * 256 + wr * 64 + fr;
#pragma unroll
            for (int i = 0; i < 4; ++i) q.v[i] = ssq[row0 + i * 16];
        } else { const int chr0 = wr * 64 + fr;
#pragma unroll
            for (int i = 0; i < 4; ++i) q.v[i] = sb[b * NIN + u.pn * 256 + chr0 + i * 16]; }
    }
    __device__ __forceinline__ void operator()(const f32x4 (&acc)[2][2][4][2], const pg8::Unit& u, int wr, int wc, int fr, int fq, const Pre& pq) const {
        if (noact == 2) {
#pragma unroll
            for (int ai = 0; ai < 2; ++ai)
#pragma unroll
                for (int bj = 0; bj < 2; ++bj)
#pragma unroll
                    for (int m = 0; m < 4; ++m)
#pragma unroll
                        for (int n = 0; n < 2; ++n) asm volatile("" :: "v"(acc[ai][bj][m][n]));
            return; }
        const int b = batch_of_tile(u.pm);
        if (u.pn < 9) {
            const int act = noact ? 0 : (0x11819u >> (2 * u.pn)) & 3;
            const int row0 = u.pm * 256 + wr * 64 + fr, colt = u.pn * 256 + wc * 32 + 8 * fq;
            f32x4 bv[2][2];
#pragma unroll
            for (int bj = 0; bj < 2; ++bj)
#pragma unroll
                for (int n = 0; n < 2; ++n) bv[bj][n] = *(const f32x4*)(sb + b * NIN + colt + bj * 128 + 4 * n);
            float sq[2][4];
#pragma unroll
            for (int ai = 0; ai < 2; ++ai)
#pragma unroll
                for (int m = 0; m < 4; ++m) sq[ai][m] = ai == 0 ? pq.v[m] : ssq[row0 + 128 + m * 16];
#pragma unroll
            for (int ai = 0; ai < 2; ++ai)
#pragma unroll
                for (int m = 0; m < 4; ++m) {
                    const int row = row0 + ai * 128 + m * 16;
                    const float rs = __builtin_amdgcn_rsqf(sq[ai][m] * (1.f / 1024.f) + RMS_EPS);
                    bf16_t* rowp = Z + (size_t)row * ZW + colt;
#pragma unroll
                    for (int bj = 0; bj < 2; ++bj) {
                        f32x4 v0 = acc[ai][bj][m][0] * rs + bv[bj][0], v1 = acc[ai][bj][m][1] * rs + bv[bj][1];
                        if (act == 1) {
#pragma unroll
                            for (int e = 0; e < 4; ++e) { v0[e] = silu_(v0[e]); v1[e] = silu_(v1[e]); }
                        } else if (act == 2) {
#pragma unroll
                            for (int e = 0; e < 4; ++e) { v0[e] = gelu_(v0[e]); v1[e] = gelu_(v1[e]); }
                        }
                        u32x4 w; w.x = cvt_pk_bf16(v0[0], v0[1]); w.y = cvt_pk_bf16(v0[2], v0[3]); w.z = cvt_pk_bf16(v1[0], v1[1]); w.w = cvt_pk_bf16(v1[2], v1[3]);
                        *(u32x4*)(rowp + bj * 128) = w;
                    }
                }
        } else {
            const int chr0 = wr * 64 + fr, tok0 = u.pm * 256 + wc * 32 + 8 * fq, zr = (u.pn - 9) * 256;
            const bool f16out = u.pn != 11;
            f32x4 rv[2][2];
#pragma unroll
            for (int bj = 0; bj < 2; ++bj)
#pragma unroll
                for (int n = 0; n < 2; ++n) { const f32x4 s = *(const f32x4*)(ssq + tok0 + bj * 128 + 4 * n);
#pragma unroll
                    for (int e = 0; e < 4; ++e) rv[bj][n][e] = __builtin_amdgcn_rsqf(s[e] * (1.f / 1024.f) + RMS_EPS); }
            float bs8[2][4];
#pragma unroll
            for (int ai = 0; ai < 2; ++ai)
#pragma unroll
                for (int m = 0; m < 4; ++m) bs8[ai][m] = ai == 0 ? pq.v[m] : sb[b * NIN + u.pn * 256 + chr0 + 128 + m * 16];
#pragma unroll
            for (int ai = 0; ai < 2; ++ai)
#pragma unroll
                for (int m = 0; m < 4; ++m) {
                    const int ch = chr0 + ai * 128 + m * 16;
                    const float bias = bs8[ai][m];
                    u16* rowp = ZT + (size_t)(zr + ch) * MTOK + tok0;
#pragma unroll
                    for (int bj = 0; bj < 2; ++bj) {
                        const f32x4 v0 = acc[ai][bj][m][0] * rv[bj][0] + bias, v1 = acc[ai][bj][m][1] * rv[bj][1] + bias;
                        u32x4 w;
                        if (f16out) { w.x = pkh(v0[0], v0[1]); w.y = pkh(v0[2], v0[3]); w.z = pkh(v1[0], v1[1]); w.w = pkh(v1[2], v1[3]); }
                        else { w.x = cvt_pk_bf16(v0[0], v0[1]); w.y = cvt_pk_bf16(v0[2], v0[3]); w.z = cvt_pk_bf16(v1[0], v1[1]); w.w = cvt_pk_bf16(v1[2], v1[3]); }
                        *(u32x4*)(rowp + bj * 128) = w;
                    }
                }
        }
    }
};
struct Epi2 {
    static constexpr bool PERM = true, AFTER_DRAIN = false;
    u16* X16; float* ssq; const float* gate; float gscale;
    struct Pre { u32x4 x0[2]; };
    __device__ __forceinline__ void prefetch(Pre& q, const pg8::Unit& u, int wr, int wc, int fr, int fq) const {
        const u16* xr = X16 + (size_t)(u.pm * 256 + wr * 64 + fr) * D + u.pn * 256 + wc * 32 + 8 * fq; q.x0[0] = *(const u32x4*)xr; q.x0[1] = *(const u32x4*)(xr + 128); }
    __device__ __forceinline__ void operator()(const f32x4 (&acc)[2][2][4][2], const pg8::Unit& u, int wr, int wc, int fr, int fq, const Pre& pq) const {
        const int b = batch_of_tile(u.pm);
        const int row0 = u.pm * 256 + wr * 64 + fr, col0 = u.pn * 256 + wc * 32 + 8 * fq;
        f32x4 gv[2][2];
#pragma unroll
        for (int bj = 0; bj < 2; ++bj)
#pragma unroll
            for (int n = 0; n < 2; ++n) gv[bj][n] = *(const f32x4*)(gate + b * NIN + col0 + bj * 128 + 4 * n) * gscale;
        u32x4 xv[5][2];
#define E2_LOAD(k) do { u16* xr = X16 + (size_t)(row0 + ((k) >> 2) * 128 + ((k) & 3) * 16) * D + col0; xv[(k) % 5][0] = *(const u32x4*)xr; xv[(k) % 5][1] = *(const u32x4*)(xr + 128); } while (0)
        xv[0][0] = pq.x0[0]; xv[0][1] = pq.x0[1]; E2_LOAD(1); E2_LOAD(2); E2_LOAD(3);
#pragma unroll
        for (int k = 0; k < 8; ++k) {
            __builtin_amdgcn_sched_barrier(0);
            if (k + 4 < 8) E2_LOAD(k + 4);
            __builtin_amdgcn_sched_barrier(0);
            const int ai = k >> 2, m = k & 3; const int row = row0 + ai * 128 + m * 16;
            u16* xr = X16 + (size_t)row * D + col0;
            float ss = 0.f;
#pragma unroll
            for (int bj = 0; bj < 2; ++bj) {
                const f16x8 h = __builtin_bit_cast(f16x8, xv[k % 5][bj]);
                f32x4 x0, x1;
#pragma unroll
                for (int e = 0; e < 4; ++e) { x0[e] = (float)h[e]; x1[e] = (float)h[4 + e]; }
                x0 = x0 + gv[bj][0] * acc[ai][bj][m][0]; x1 = x1 + gv[bj][1] * acc[ai][bj][m][1];
                ss += (x0[0] * x0[0] + x0[1] * x0[1]) + (x0[2] * x0[2] + x0[3] * x0[3]) + (x1[0] * x1[0] + x1[1] * x1[1]) + (x1[2] * x1[2] + x1[3] * x1[3]);
                u32x4 w; w.x = pkh(x0[0], x0[1]); w.y = pkh(x0[2], x0[3]); w.z = pkh(x1[0], x1[1]); w.w = pkh(x1[2], x1[3]);
                *(u32x4*)(xr + bj * 128) = w;
            }
            ss += __shfl_xor(ss, 16); ss += __shfl_xor(ss, 32);
            if (fq == 0) atomicAdd(ssq + row, ss);
        }
#undef E2_LOAD
    }
};

__device__ __forceinline__ void transpose_item(const float* src, int pitch, int ncols, int K, bf16_t* dst, LAS float* scr, int item, int lane) {
    const int nblk = ncols / 32, kb = item / nblk, nb = item % nblk, k0 = 64 * kb, n0 = 32 * nb;
    f32x4 ld[8];
#pragma unroll
    for (int i = 0; i < 8; ++i) { const int kk = 8 * i + (lane >> 3); ld[i] = *(const f32x4*)(src + (size_t)(k0 + kk) * pitch + n0 + 4 * (lane & 7)); }
#pragma unroll
    for (int i = 0; i < 8; ++i) { const int kk = 8 * i + (lane >> 3); LAS float* d = scr + kk * 33 + 4 * (lane & 7); d[0] = ld[i][0]; d[1] = ld[i][1]; d[2] = ld[i][2]; d[3] = ld[i][3]; }
    asm volatile("s_waitcnt lgkmcnt(0)" ::: "memory");
    const int c = lane & 7;
#pragma unroll
    for (int j = 0; j < 4; ++j) { const int n = (lane >> 3) + 8 * j; const LAS float* s = scr + (8 * c) * 33 + n;
        u32x4 o; o.x = cvt_pk_bf16(s[0 * 33], s[1 * 33]); o.y = cvt_pk_bf16(s[2 * 33], s[3 * 33]); o.z = cvt_pk_bf16(s[4 * 33], s[5 * 33]); o.w = cvt_pk_bf16(s[6 * 33], s[7 * 33]);
        *(u32x4*)(dst + (size_t)(n0 + n) * K + k0 + 8 * c) = o; }
    asm volatile("s_waitcnt lgkmcnt(0)" ::: "memory");
}

__device__ __forceinline__ void phase_p0a(const Params& p, LAS unsigned char* lds, int bid, int G, int tid, int lane, int wave) {
    asm volatile("" : "+v"(tid), "+v"(lane), "+s"(wave), "+s"(bid), "+s"(G));
    size_t wso = 0; asm volatile("" : "+s"(wso)); unsigned char* ws = p.ws + wso;
    const float* w_in = p.in[7]; const float* w_out = p.in[8];
    bf16_t* WinT = (bf16_t*)(ws + WS_WIN); bf16_t* WoutT = (bf16_t*)(ws + WS_WOUT);
    const int gw = bid * 8 + wave, NGW = G * 8, gtid = bid * NTHR + tid, NT = G * NTHR;
    {
        LAS float* scr = (LAS float*)(lds + wave * 8448);
        for (int it = gw; it < 4608 + 2048; it += NGW) {
            if (it < 4608) {
                const int sub = it & 127, lt = it >> 7, l = lt / 9, ti = lt % 9;
                const int pn = ti < 4 ? ti : (ti < 8 ? ti + 1 : 11);
                const int sc = ti == 0 ? 256 : ti == 1 ? 512 : ti == 2 ? 1536 : ti == 3 ? 1792 : ti == 4 ? 768 : ti == 5 ? 1024 : ti == 6 ? 2048 : ti == 7 ? 2560 : 2304;
                transpose_item(w_in + (size_t)l * D * DIN + sc, DIN, 256, D, WinT + ((size_t)l * NIN + pn * 256) * D, scr, sub, lane);
            } else {
                const int r = it - 4608, l = r >> 9, sub = r & 511;
                transpose_item(w_out + (size_t)l * D * D, D, D, D, WoutT + (size_t)l * D * D, scr, sub, lane);
            }
        }
    }
    __syncthreads();
    {
        const float* pool_w = p.in[9]; const float* pool_scale = p.in[10]; const float* fnet_w = p.in[14];
        LAS float* Mf = (LAS float*)lds; LAS float* Wt = (LAS float*)(lds + 16384); LAS float* cs = (LAS float*)(lds + 33024); LAS u16* Ot = (LAS u16*)(lds + 36864); LAS float* Fw = (LAS float*)(lds + 46080);
        for (int it = bid; it < 768; it += G) {
            const int kb = it & 15, g = (it >> 4) & 3, kind = (it >> 6) % 3, l = it / 192;
            if (tid < 64) { cs[tid] = cospif((float)tid * (1.f / 32.f)); cs[64 + tid] = sinpif((float)tid * (1.f / 32.f)); }
            const float* wsrc = w_in + (size_t)l * D * DIN + (kind == 0 ? 0 : 1280) + g * 64;
#pragma unroll
            for (int i = 0; i < 8; ++i) { const int e = tid + 512 * i, kk = e >> 6, c = e & 63; Wt[kk * 65 + c] = wsrc[(size_t)(kb * 64 + kk) * DIN + c]; }
            if (kind != 0) {
#pragma unroll
                for (int i = 0; i < 8; ++i) { const int e = tid + 512 * i; Fw[e] = fnet_w[(l * 4 + g) * 4096 + e]; } }
            __syncthreads();
#pragma unroll 1
            for (int i = 0; i < 8; ++i) {
                const int e = tid + 512 * i, c = e >> 6, d = e & 63; float v;
                if (kind == 0) v = pool_w[((l * 4 + g) * 64 + c) * 64 + d] * pool_scale[l * 256 + g * 64 + d];
                else { float s = 0.f; const int co = kind == 1 ? 0 : 64;
#pragma unroll 16
                    for (int cp = 0; cp < 64; ++cp) s += cs[co + ((c * cp) & 63)] * Fw[cp * 64 + d];
                    v = s * (kind == 1 ? 0.125f : -0.125f); }
                Mf[c * 64 + d] = v;
            }
            __syncthreads();
#pragma unroll 1
            for (int i = 0; i < 8; ++i) { const int kk = wave + 8 * i; float s = 0.f;
#pragma unroll 16
                for (int c = 0; c < 64; ++c) s += Wt[kk * 65 + c] * Mf[c * 64 + lane];
                Ot[lane * 72 + kk] = (u16)f2bf(s); }
            __syncthreads();
            { const int d = tid >> 3, ch = tid & 7, pn = kind == 0 ? 4 : (kind == 1 ? 9 : 10);
              const u32x4 v = *(const LAS u32x4*)(Ot + d * 72 + ch * 8);
              *(u32x4*)(WinT + ((size_t)l * NIN + pn * 256 + g * 64 + d) * D + kb * 64 + ch * 8) = v; }
            __syncthreads();
        }
    }
    { const f32x4* s4 = (const f32x4*)p.in[12]; u32x2* d2 = (u32x2*)(ws + WS_SGUW);
      for (int e = gtid; e < 65536; e += NT) { const f32x4 v = s4[e]; u32x2 o; o.x = cvt_pk_bf16(v[0], v[1]); o.y = cvt_pk_bf16(v[2], v[3]); d2[e] = o; } }
    {
        const float* cp_ = p.in[2]; const float* cs_ = p.in[3]; const float* w_ada = p.in[5]; const float* b_ada = p.in[6]; float* mod = (float*)(ws + WS_MOD);
        LAS float* sc = (LAS float*)lds; LAS float* red = (LAS float*)(lds + 40960);
        for (int it = bid; it < 192; it += G) {
            const int l = it / 48, jb = it % 48;
            for (int e = tid; e < 10240; e += NTHR) { const int b = e >> 10, k = e & 1023; const float cv = b < 8 ? cp_[b * 1024 + k] : cs_[(b - 8) * 1024 + k]; sc[e] = cv / (1.f + expf(-cv)); }
            __syncthreads();
            float a[10];
#pragma unroll
            for (int b = 0; b < 10; ++b) a[b] = 0.f;
            const float* wp = w_ada + ((size_t)l * 1024 + wave * 128) * 3072 + jb * 64 + lane;
#pragma unroll 16
            for (int kk = 0; kk < 128; ++kk) { const float wv = wp[(size_t)kk * 3072];
#pragma unroll
                for (int b = 0; b < 10; ++b) a[b] += sc[b * 1024 + wave * 128 + kk] * wv; }
#pragma unroll
            for (int b = 0; b < 10; ++b) red[(wave * 10 + b) * 64 + lane] = a[b];
            __syncthreads();
            for (int e = tid; e < 640; e += NTHR) { const int b = e >> 6, j = e & 63; float s = 0.f;
#pragma unroll
                for (int w = 0; w < 8; ++w) s += red[(w * 10 + b) * 64 + j];
                mod[(l * 10 + b) * 3072 + jb * 64 + j] = s + b_ada[l * 3072 + jb * 64 + j]; }
            __syncthreads();
        }
    }
    {
        _Float16* C128 = (_Float16*)(ws + WS_DFT + DF_C128); _Float16* S128 = (_Float16*)(ws + WS_DFT + DF_S128); _Float16* NS128 = (_Float16*)(ws + WS_DFT + DF_NS128);
        _Float16* T1 = (_Float16*)(ws + WS_DFT + DF_T1); _Float16* T2 = (_Float16*)(ws + WS_DFT + DF_T2);
        float* TW16K = (float*)(ws + WS_DFT + DF_TW16K); float* TW2K = (float*)(ws + WS_DFT + DF_TW2K);
        for (int e = gtid; e < 16384; e += NT) {
            const int k = e >> 7, n = e & 127, m = (k * n) & 127;
            const float c = cospif((float)m * (1.f / 64.f)) * 0.08838834764831845f, s = sinpif((float)m * (1.f / 64.f)) * 0.08838834764831845f;
            C128[e] = (_Float16)c; S128[e] = (_Float16)s; NS128[e] = (_Float16)(-s);
            const float ang = (float)(k * n) * (1.f / 8192.f);
            TW16K[2 * e] = cospif(ang); TW16K[2 * e + 1] = -sinpif(ang);
        }
        for (int e = gtid; e < 512; e += NT) {
            const int k1 = e >> 5, kk = e & 31, n1 = kk & 15, m = (k1 * n1) & 15;
            const float c = cospif((float)m * 0.125f) * 0.25f, s = sinpif((float)m * 0.125f) * 0.25f;
            T1[e] = (_Float16)(kk < 16 ? c : s); T2[e] = (_Float16)(kk < 16 ? -s : c);
        }
        for (int e = gtid; e < 2048; e += NT) {
            const int k1 = e >> 7, n2 = e & 127; const float ang = (float)(k1 * n2) * (1.f / 1024.f);
            TW2K[2 * e] = cospif(ang); TW2K[2 * e + 1] = -sinpif(ang);
        }
    }
}

__device__ __forceinline__ void gen_w16(const Params& p, unsigned char* ws, int l, int gtid, int NT) {
    const bf16_t* Wm = (const bf16_t*)(ws + WS_WIN) + (size_t)l * NIN * D; u16* W16 = (u16*)(ws + WS_W16);
    const float* sc = (const float*)(ws + WS_MOD) + (size_t)l * NB * 3072 + 1024; const float* ng = p.in[4] + l * D;
    for (int idx = gtid; idx < NIN * 128; idx += NT) {
        const int n = idx >> 7, k8 = (idx & 127) * 8;
        const u32x4 wraw = *(const u32x4*)(Wm + (size_t)n * D + k8);
        const f32x4 g0 = *(const f32x4*)(ng + k8), g1 = *(const f32x4*)(ng + k8 + 4);
        f32x4 s0[NB], s1[NB];
#pragma unroll
        for (int b = 0; b < NB; ++b) { s0[b] = *(const f32x4*)(sc + b * 3072 + k8); s1[b] = *(const f32x4*)(sc + b * 3072 + k8 + 4); }
        __builtin_amdgcn_sched_barrier(0);
        float w[8]; unpack8(wraw, w);
#pragma unroll
        for (int b = 0; b < NB; ++b) {
            const f32x4 m0 = g0 * (1.f + s0[b]), m1 = g1 * (1.f + s1[b]);
            u32x4 o; o.x = pkh(w[0] * m0[0], w[1] * m0[1]); o.y = pkh(w[2] * m0[2], w[3] * m0[3]); o.z = pkh(w[4] * m1[0], w[5] * m1[1]); o.w = pkh(w[6] * m1[2], w[7] * m1[3]);
            *(u32x4*)(W16 + ((size_t)b * NIN + n) * D + k8) = o;
        }
    }
}

__device__ __forceinline__ void phase_p0b(const Params& p, LAS unsigned char* lds, int bid, int G, int tid, int lane, int wave) {
    asm volatile("" : "+v"(tid), "+v"(lane), "+s"(wave), "+s"(bid), "+s"(G));
    size_t wso = 0; asm volatile("" : "+s"(wso)); unsigned char* ws = p.ws + wso;
    const float* mod = (const float*)(ws + WS_MOD); const float* norm_g = p.in[4];
    const int gw = bid * 8 + wave, NGW = G * 8, gtid = bid * NTHR + tid, NT = G * NTHR;
    {
        const bf16_t* WinT = (const bf16_t*)(ws + WS_WIN); float* sb = (float*)(ws + WS_SB);
        const int fr = lane & 15, quad = lane >> 4;
        for (int it = gw; it < NLAYER * (NIN / 16); it += NGW) {
            const int l = it / (NIN / 16), n0 = (it % (NIN / 16)) * 16;
            const bf16_t* wrow = WinT + ((size_t)l * NIN + n0 + fr) * D + quad * 8;
            const float* srow = mod + (size_t)(l * NB + (fr < NB ? fr : 0)) * 3072 + quad * 8;
            f32x4 acc0 = (f32x4){0.f, 0.f, 0.f, 0.f}, acc1 = acc0;
#pragma unroll 1
            for (int kh = 0; kh < 2; ++kh) {
                bf16x8 bw[16]; f32x4 sa[16][2];
#pragma unroll
                for (int ks = 0; ks < 16; ++ks) { const int k0 = (kh * 16 + ks) * 32; bw[ks] = *(const bf16x8*)(wrow + k0); sa[ks][0] = *(const f32x4*)(srow + k0); sa[ks][1] = *(const f32x4*)(srow + k0 + 4); }
                __builtin_amdgcn_sched_barrier(0);
#pragma unroll
                for (int ks = 0; ks < 16; ++ks) {
                    u32x4 aw; aw.x = cvt_pk_bf16(sa[ks][0][0], sa[ks][0][1]); aw.y = cvt_pk_bf16(sa[ks][0][2], sa[ks][0][3]); aw.z = cvt_pk_bf16(sa[ks][1][0], sa[ks][1][1]); aw.w = cvt_pk_bf16(sa[ks][1][2], sa[ks][1][3]);
                    if (fr >= NB) aw = (u32x4){0u, 0u, 0u, 0u};
                    if (ks & 1) acc1 = mma_bf16(__builtin_bit_cast(bf16x8, aw), bw[ks], acc1); else acc0 = mma_bf16(__builtin_bit_cast(bf16x8, aw), bw[ks], acc0);
                }
            }
#pragma unroll
            for (int j = 0; j < 4; ++j) { const int b = quad * 4 + j; if (b < NB) sb[(size_t)(l * NB + b) * NIN + n0 + fr] = acc0[j] + acc1[j]; }
        }
    }
    {
        u16* X16 = (u16*)(ws + WS_X16); float* ssq = (float*)(ws + WS_SSQ);
        for (int row0 = gw * 8; row0 < MTOK; row0 += NGW * 8) {
            const float* xr = row0 < NPT ? p.in[0] + (size_t)row0 * D : p.in[1] + (size_t)(row0 - NPT) * D;
            f32x4 v[8][4];
#pragma unroll
            for (int r = 0; r < 8; ++r)
#pragma unroll
                for (int j = 0; j < 4; ++j) v[r][j] = *(const f32x4*)(xr + (size_t)r * D + 4 * (lane + 64 * j));
            __builtin_amdgcn_sched_barrier(0);
#pragma unroll
            for (int r = 0; r < 8; ++r) {
                float ss = 0.f;
#pragma unroll
                for (int j = 0; j < 4; ++j) {
                    const f32x4 x = v[r][j];
                    ss += (x[0] * x[0] + x[1] * x[1]) + (x[2] * x[2] + x[3] * x[3]);
                    u32x2 o; o.x = pkh(x[0], x[1]); o.y = pkh(x[2], x[3]);
                    *(u32x2*)(X16 + (size_t)(row0 + r) * D + 4 * (lane + 64 * j)) = o;
                }
                ss = wave_sum(ss);
                if (lane == 0) ssq[row0 + r] = ss;
            }
        }
    }
    gen_w16(p, ws, 0, gtid, NT);
}

__device__ __forceinline__ void phase_final(const Params& p, int bid, int G, int lane, int wave) {
    const float* ssq = (const float*)(p.ws + WS_SSQ); const float* fg = p.in[16]; const u16* X16 = (const u16*)(p.ws + WS_X16);
    const int gw = bid * 8 + wave, NGW = G * 8;
    for (int row0 = gw * 8; row0 < MTOK; row0 += NGW * 8) {
        u32x4 xh[8][2]; float sq[8];
#pragma unroll
        for (int r = 0; r < 8; ++r) { sq[r] = ssq[row0 + r]; xh[r][0] = *(const u32x4*)(X16 + (size_t)(row0 + r) * D + lane * 8); xh[r][1] = *(const u32x4*)(X16 + (size_t)(row0 + r) * D + 512 + lane * 8); }
        f32x4 g[2][2];
#pragma unroll
        for (int hh = 0; hh < 2; ++hh) { g[hh][0] = *(const f32x4*)(fg + hh * 512 + lane * 8); g[hh][1] = *(const f32x4*)(fg + hh * 512 + lane * 8 + 4); }
        __builtin_amdgcn_sched_barrier(0);
#pragma unroll
        for (int r = 0; r < 8; ++r) { const float rs = __builtin_amdgcn_rsqf(sq[r] * (1.f / 1024.f) + RMS_EPS);
            float* orow = p.out + (size_t)(row0 + r) * D + lane * 8;
#pragma unroll
            for (int hh = 0; hh < 2; ++hh) { const f16x8 h = __builtin_bit_cast(f16x8, xh[r][hh]);
                f32x4 a, c;
#pragma unroll
                for (int e = 0; e < 4; ++e) { a[e] = (float)h[e] * rs; c[e] = (float)h[4 + e] * rs; }
                *(f32x4*)(orow + hh * 512) = a * g[hh][0]; *(f32x4*)(orow + hh * 512 + 4) = c * g[hh][1]; } }
    }
}

constexpr int FP = 272;
constexpr int F_UP = 0, F_UQ = 34816, F_APR = 69632, F_API = 104448, F_YST = 0;

__device__ __forceinline__ void phase_p2a(const Params& p, LAS unsigned char* lds, int bid, int G, int tid, int lane, int wave, const int mode = 3) {
    asm volatile("" : "+v"(tid), "+v"(lane), "+s"(wave), "+s"(bid), "+s"(G));
    size_t wso = 0; asm volatile("" : "+s"(wso)); unsigned char* ws = p.ws + wso;
    const int gtid = bid * NTHR + tid, NT = G * NTHR, fr = lane & 15, quad = lane >> 4;
    { float* ssq = (float*)(ws + WS_SSQ); for (int e = gtid; e < MTOK; e += NT) ssq[e] = 0.f; }
    const u16* ZT = (const u16*)(ws + WS_ZT); u16* YT = (u16*)(ws + WS_ZT);
    const bf16x8* C128 = (const bf16x8*)(ws + WS_DFT + DF_C128); const bf16x8* S128 = (const bf16x8*)(ws + WS_DFT + DF_S128); const bf16x8* NS128 = (const bf16x8*)(ws + WS_DFT + DF_NS128);
    const bf16x8* T1 = (const bf16x8*)(ws + WS_DFT + DF_T1); const bf16x8* T2 = (const bf16x8*)(ws + WS_DFT + DF_T2);
    const f32x2* TW16K = (const f32x2*)(ws + WS_DFT + DF_TW16K); const f32x2* TW2K = (const f32x2*)(ws + WS_DFT + DF_TW2K);
    u32x4 stU[8];
#define FFT_ISSUE(uu) do { const bool big_ = (uu) < 512; int bs_, ch0_; \
        if (big_) { bs_ = NPT + ((uu) >> 8) * 16384; ch0_ = (uu) & 255; } else { const int v_ = (uu) - 512; bs_ = (v_ >> 5) * 2048; ch0_ = (v_ & 31) * 8; } \
        _Pragma("unroll") for (int i = 0; i < 8; ++i) { const int c = tid + 512 * i, mat = c >> 11, cc = c & 2047, r = cc >> 4, k16 = cc & 15; \
            const int chan = big_ ? ch0_ : ch0_ + (r >> 4), roff = big_ ? r * 128 : (r & 15) * 128; \
            stU[i] = *(const u32x4*)(ZT + (size_t)(mat * 256 + chan) * MTOK + bs_ + roff + k16 * 8); } } while (0)
    if ((mode & 1) && bid < 768) FFT_ISSUE(bid);
    bf16x8 cf[4], sf[4], nsf[4];
#pragma unroll
    for (int ks = 0; ks < 4; ++ks) { const int off = ((wave * 16 + fr) * 128 + ks * 32 + quad * 8) >> 3; cf[ks] = C128[off]; sf[ks] = S128[off]; nsf[ks] = NS128[off]; }
    if (mode & 1)
    for (int u = bid; u < 768; u += G) {
        const bool big = u < 512;
        int bs, ch0;
        if (big) { bs = NPT + (u >> 8) * 16384; ch0 = u & 255; } else { const int v = u - 512; bs = (v >> 5) * 2048; ch0 = (v & 31) * 8; }
#pragma unroll
        for (int i = 0; i < 8; ++i) { const int c = tid + 512 * i, mat = c >> 11, cc = c & 2047, r = cc >> 4, k16 = cc & 15; *(LAS u32x4*)(lds + mat * 34816 + r * FP + k16 * 16) = stU[i]; }
        f32x2 twn[4];
#pragma unroll
        for (int j = 0; j < 4; ++j) twn[j] = big ? TW16K[(wave * 16 + quad * 4 + j) * 128 + fr] : TW2K[(quad * 4 + j) * 128 + fr];
        __syncthreads();
        { const int un = (u + G < 768) ? u + G : u; FFT_ISSUE(un); }
        __builtin_amdgcn_sched_barrier(0);
        if (big) {
            const int mt = wave;
#pragma unroll 2
            for (int nt = 0; nt < 8; ++nt) {
                f32x2 twc[4];
#pragma unroll
                for (int j = 0; j < 4; ++j) { twc[j] = twn[j]; twn[j] = TW16K[(mt * 16 + quad * 4 + j) * 128 + min(nt + 1, 7) * 16 + fr]; }
                bf16x8 bu[4], bi[4];
#pragma unroll
                for (int ks = 0; ks < 4; ++ks) { bu[ks] = tr_frag(lds + F_UP, FP, ks * 32 + quad * 8, nt * 16, lane); bi[ks] = tr_frag(lds + F_UQ, FP, ks * 32 + quad * 8, nt * 16, lane); }
                f32x4 ar = (f32x4){0.f, 0.f, 0.f, 0.f}, ai = (f32x4){0.f, 0.f, 0.f, 0.f};
#pragma unroll
                for (int ks = 0; ks < 4; ++ks) { ar = mma_f16(cf[ks], bu[ks], ar); ar = mma_f16(sf[ks], bi[ks], ar); ai = mma_f16(cf[ks], bi[ks], ai); ai = mma_f16(nsf[ks], bu[ks], ai); }
                const int n2 = nt * 16 + fr;
                f16x4 pr, pi;
#pragma unroll
                for (int j = 0; j < 4; ++j) { const f32x2 t2_ = twc[j];
                    pr[j] = (_Float16)(ar[j] * t2_.x - ai[j] * t2_.y); pi[j] = (_Float16)(ar[j] * t2_.y + ai[j] * t2_.x); }
                *(LAS f16x4*)(lds + F_APR + n2 * FP + (mt * 16 + quad * 4) * 2) = pr;
                *(LAS f16x4*)(lds + F_API + n2 * FP + (mt * 16 + quad * 4) * 2) = pi;
            }
        } else {
            const bf16x8 t1 = T1[(fr * 32 + quad * 8) >> 3], t2 = T2[(fr * 32 + quad * 8) >> 3];
#pragma unroll 2
            for (int nt = 0; nt < 8; ++nt) {
                const bf16x8 bf = tr_frag(lds + (quad < 2 ? F_UP : F_UQ), FP, wave * 16 + (quad & 1) * 8, nt * 16, lane);
                f32x2 twc[4];
#pragma unroll
                for (int j = 0; j < 4; ++j) { twc[j] = twn[j]; twn[j] = TW2K[(quad * 4 + j) * 128 + min(nt + 1, 7) * 16 + fr]; }
                const f32x4 z4 = (f32x4){0.f, 0.f, 0.f, 0.f};
                const f32x4 ar = mma_f16(t1, bf, z4), ai = mma_f16(t2, bf, z4);
                const int n2 = nt * 16 + fr;
                f16x4 pr, pi;
#pragma unroll
                for (int j = 0; j < 4; ++j) { const f32x2 tw = twc[j];
                    pr[j] = (_Float16)(ar[j] * tw.x - ai[j] * tw.y); pi[j] = (_Float16)(ar[j] * tw.y + ai[j] * tw.x); }
                *(LAS f16x4*)(lds + F_APR + n2 * FP + (wave * 16 + quad * 4) * 2) = pr;
                *(LAS f16x4*)(lds + F_API + n2 * FP + (wave * 16 + quad * 4) * 2) = pi;
            }
        }
        __syncthreads();
        {
            const int mt = wave;
#pragma unroll 2
            for (int nt = 0; nt < 8; ++nt) {
                bf16x8 br[4], bq[4];
#pragma unroll
                for (int ks = 0; ks < 4; ++ks) { br[ks] = tr_frag(lds + F_APR, FP, ks * 32 + quad * 8, nt * 16, lane); bq[ks] = tr_frag(lds + F_API, FP, ks * 32 + quad * 8, nt * 16, lane); }
                f32x4 y = (f32x4){0.f, 0.f, 0.f, 0.f};
#pragma unroll
                for (int ks = 0; ks < 4; ++ks) { y = mma_f16(cf[ks], br[ks], y); y = mma_f16(sf[ks], bq[ks], y); }
                const int col = nt * 16 + fr;
#pragma unroll
                for (int j = 0; j < 4; ++j) { const int k2 = mt * 16 + quad * 4 + j; *(LAS _Float16*)(lds + F_YST + (k2 * 128 + col) * 2) = (_Float16)y[j]; }
            }
        }
        __syncthreads();
#pragma unroll
        for (int i = 0; i < 4; ++i) {
            const int c = tid + 512 * i;
            if (big) { const u32x4 v = *(const LAS u32x4*)(lds + F_YST + c * 16); *(u32x4*)(YT + (size_t)ch0 * MTOK + bs + c * 8) = v; }
            else { const int chl = c >> 8, k2 = (c & 255) >> 1, h8 = c & 1;
                const u32x4 v = *(const LAS u32x4*)(lds + F_YST + (k2 * 128 + chl * 16 + h8 * 8) * 2);
                *(u32x4*)(YT + (size_t)(ch0 + chl) * MTOK + bs + k2 * 16 + h8 * 8) = v; }
        }
        __syncthreads();
    }
    if (mode & 2) {
        bf16_t* Z = (bf16_t*)(ws + WS_Z);
        for (int idx = gtid; idx < (MTOK / 4) * 32; idx += NT) {
            const int t0 = (idx >> 5) * 4, cg8 = idx & 31, g = cg8 >> 3, half = 1 << g;
            const int b = batch_of_tok(t0), bs = b < 8 ? b * 2048 : NPT + (b - 8) * 16384, be = bs + (b < 8 ? 2048 : 16384);
            const bf16_t* ap = Z + 1024 + cg8 * 8;
            u32x4 rw[19], gt4[4];
#pragma unroll
            for (int i = 0; i < 19; ++i) { const int off = i - 8, tt = t0 + off; rw[i] = (u32x4){0u, 0u, 0u, 0u}; if (off >= -half && off < 3 + half && tt >= bs && tt < be) rw[i] = *(const u32x4*)(ap + (size_t)tt * ZW); }
#pragma unroll
            for (int k = 0; k < 4; ++k) gt4[k] = *(const u32x4*)(Z + (size_t)(t0 + k) * ZW + cg8 * 8);
            __builtin_amdgcn_sched_barrier(0);
            float s[4][8];
#pragma unroll
            for (int k = 0; k < 4; ++k)
#pragma unroll
                for (int e = 0; e < 8; ++e) s[k][e] = 0.f;
#pragma unroll
            for (int i = 0; i < 19; ++i) { float f[8]; unpack8(rw[i], f); const int off = i - 8;
#pragma unroll
                for (int k = 0; k < 4; ++k) { const bool in = (off >= k - half) && (off < k + half);
#pragma unroll
                    for (int e = 0; e < 8; ++e) s[k][e] += in ? f[e] : 0.f; } }
#pragma unroll
            for (int k = 0; k < 4; ++k) {
                const int t = t0 + k, lo = max(t - half, bs), hi = min(t + half, be);
                const float inv = 1.f / (float)(hi - lo);
                float a[8], gt[8]; unpack8(rw[8 + k], a); unpack8(gt4[k], gt);
                float o[8];
#pragma unroll
                for (int e = 0; e < 8; ++e) o[e] = (s[k][e] * inv - a[e]) * gt[e];
                u32x4 w; w.x = cvt_pk_bf16(o[0], o[1]); w.y = cvt_pk_bf16(o[2], o[3]); w.z = cvt_pk_bf16(o[4], o[5]); w.w = cvt_pk_bf16(o[6], o[7]);
                bf16_t* op = (mode & 4) ? (bf16_t*)(ws + WS_END) + (size_t)t * 256 + cg8 * 8 : Z + (size_t)t * ZW + cg8 * 8;
                *(u32x4*)op = w;
            }
        }
    }
}

constexpr int VP = 528;
constexpr int SGS_OFF = 69632;
constexpr int NAK_OFF = 0, NAKP = 144, NAV_OFF = 73728, NAVP = 1040;
constexpr int RPB_OFF = 140288;
constexpr int NAEX_OFF = 147728;

__device__ __forceinline__ void phase_p2b(const Params& p, LAS unsigned char* lds, int l, int bid, int G, int tid, int lane, int wave, const int mode = 7) {
    asm volatile("" : "+v"(tid), "+v"(lane), "+s"(wave), "+s"(bid), "+s"(G));
    size_t wso = 0; asm volatile("" : "+s"(wso)); unsigned char* ws = p.ws + wso;
    bf16_t* Z = (bf16_t*)(ws + WS_Z);
    const int fr = lane & 15, quad = lane >> 4;
    { LAS float* rp = (LAS float*)(lds + RPB_OFF); const float* src = p.in[15] + l * 1860; for (int e = tid; e < 1860; e += NTHR) rp[e] = src[e] * 1.44269504089f; }
    __syncthreads();
    bf16_t* DUM = (bf16_t*)(ws + WS_END);
    if (mode & 1) {
        const float* ng = p.in[11] + l * 256; const float* sgb = p.in[13] + l * 512; const bf16_t* SW = (const bf16_t*)(ws + WS_SGUW) + (size_t)l * 4 * 128 * 128;
        const int vcu_s = (G % 8 == 0) ? (bid % 8) * (G / 8) + bid / 8 : bid;
        for (int it = vcu_s; it < 384; it += G) {
            const int t0 = it * 128;
            {
                const int slot = tid >> 5, ck = tid & 31;
                u32x4 vraw[8];
#pragma unroll
                for (int i = 0; i < 8; ++i) vraw[i] = *(const u32x4*)(Z + (size_t)(t0 + i * 16 + slot) * ZW + 1280 + ck * 8);
                const f32x4 g0 = *(const f32x4*)(ng + ck * 8), g1 = *(const f32x4*)(ng + ck * 8 + 4);
                __builtin_amdgcn_sched_barrier(0);
#pragma unroll
                for (int i = 0; i < 8; ++i) {
                    float v[8]; unpack8(vraw[i], v);
                    float s1 = 0.f, s2 = 0.f;
#pragma unroll
                    for (int e = 0; e < 8; ++e) { s1 += v[e]; s2 += v[e] * v[e]; }
#pragma unroll
                    for (int o = 1; o < 32; o <<= 1) { s1 += __shfl_xor(s1, o); s2 += __shfl_xor(s2, o); }
                    const float mean = s1 * (1.f / 256.f), rstd = __builtin_amdgcn_rsqf(fmaxf(s2 * (1.f / 256.f) - mean * mean, 0.f) + LN_EPS);
                    u32x4 w; w.x = cvt_pk_bf16((v[0] - mean) * rstd * g0[0], (v[1] - mean) * rstd * g0[1]); w.y = cvt_pk_bf16((v[2] - mean) * rstd * g0[2], (v[3] - mean) * rstd * g0[3]);
                    w.z = cvt_pk_bf16((v[4] - mean) * rstd * g1[0], (v[5] - mean) * rstd * g1[1]); w.w = cvt_pk_bf16((v[6] - mean) * rstd * g1[2], (v[7] - mean) * rstd * g1[3]);
                    *(LAS u32x4*)(lds + (i * 16 + slot) * VP + ck * 16) = w;
                }
            }
            u32x4 uu[8];
            { const int slot = tid >> 5, ck = tid & 31;
#pragma unroll
              for (int i = 0; i < 8; ++i) uu[i] = *(const u32x4*)(Z + (size_t)(t0 + i * 16 + slot) * ZW + 256 + ck * 8); }
            {
                const int h = wave >> 1, ph = wave & 1;
                bf16x8 bw[4][4]; float bias[4];
#pragma unroll
                for (int nt = 0; nt < 4; ++nt) {
                    const int prow = ph * 64 + nt * 16 + fr;
#pragma unroll
                    for (int ks = 0; ks < 4; ++ks) bw[nt][ks] = *(const bf16x8*)(SW + ((size_t)h * 128 + prow) * 128 + ks * 32 + quad * 8);
                    bias[nt] = sgb[h * 128 + prow];
                }
                __builtin_amdgcn_sched_barrier(0);
                __syncthreads();
                bf16x8 a[4][4];
#pragma unroll
                for (int mt = 0; mt < 4; ++mt)
#pragma unroll
                    for (int ks = 0; ks < 4; ++ks) a[mt][ks] = tr_frag(lds, VP, ks * 32 + quad * 8, h * 64 + mt * 16, lane);
#pragma unroll
                for (int nt = 0; nt < 4; ++nt) {
                    f32x4 acc[4];
#pragma unroll
                    for (int mt = 0; mt < 4; ++mt) acc[mt] = (f32x4){0.f, 0.f, 0.f, 0.f};
                    const int prow = ph * 64 + nt * 16 + fr;
#pragma unroll
                    for (int ks = 0; ks < 4; ++ks)
#pragma unroll
                        for (int mt = 0; mt < 4; ++mt) acc[mt] = mma_bf16(a[mt][ks], bw[nt][ks], acc[mt]);
#pragma unroll
                    for (int mt = 0; mt < 4; ++mt) {
                        const int c = h * 64 + mt * 16 + quad * 4; const float bb = bias[nt];
                        u32x2 w; w.x = pkh(acc[mt][0] + bb, acc[mt][1] + bb); w.y = pkh(acc[mt][2] + bb, acc[mt][3] + bb);
                        *(LAS u32x2*)(lds + SGS_OFF + prow * VP + c * 2) = w;
                    }
                }
            }
            __syncthreads();
            {
                const int slot = tid >> 5, ck = tid & 31;
                u32x4 gg[8];
#pragma unroll
                for (int i = 0; i < 8; ++i) gg[i] = *(const u32x4*)(Z + (size_t)(t0 + i * 16 + slot) * ZW + 1536 + ck * 8);
                __builtin_amdgcn_sched_barrier(0);
#pragma unroll
                for (int i = 0; i < 8; ++i) {
                    const int prow = i * 16 + slot;
                    const f16x8 sv = __builtin_bit_cast(f16x8, *(const LAS u32x4*)(lds + SGS_OFF + prow * VP + ck * 16));
                    float uf[8], gf[8]; unpack8(uu[i], uf); unpack8(gg[i], gf);
                    u32x4 w; w.x = cvt_pk_bf16(uf[0] * (float)sv[0] * gf[0], uf[1] * (float)sv[1] * gf[1]); w.y = cvt_pk_bf16(uf[2] * (float)sv[2] * gf[2], uf[3] * (float)sv[3] * gf[3]);
                    w.z = cvt_pk_bf16(uf[4] * (float)sv[4] * gf[4], uf[5] * (float)sv[5] * gf[5]); w.w = cvt_pk_bf16(uf[6] * (float)sv[6] * gf[6], uf[7] * (float)sv[7] * gf[7]);
                    if (mode & 8) *(u32x4*)(DUM + (size_t)(t0 + prow) * 256 + ck * 8) = w; else *(u32x4*)(Z + (size_t)(t0 + prow) * ZW + 256 + ck * 8) = w;
                }
            }
            __syncthreads();
        }
    }
    if (mode & 2) {
        const u16* ZT = (const u16*)(ws + WS_ZT);
        const LAS float* rpb = (const LAS float*)(lds + RPB_OFF);
        const int vcu = (G % 8 == 0) ? (bid % 8) * (G / 8) + bid / 8 : bid;
        int jbeg, jend;
        if (G == 256) { jbeg = vcu * 12; jend = jbeg + 12; }
        else { const int per = (3072 + G - 1) / G; jbeg = min(3072, vcu * per); jend = min(3072, jbeg + per); }
        const int cb = wave & 3, half = wave >> 2, c0 = cb == 0 ? 0 : (cb == 1 ? 8 : (cb == 2 ? 24 : 32)), qc = cb * 16 + fr, cst = min(max(qc - 8, 0), 48);
        u32x4 stK0 = (u32x4){0u, 0u, 0u, 0u}, stV0 = stK0; bf16x8 qn[2]; u32x2 ggn[4];
#define NA_DECODE(j, h_, r_, bs_, rs_) const int h_ = ((j) / 12) & 3; int r_, bs_, rs_; { const int R_ = ((j) / 48) * 12 + (j) % 12; int rows_; \
        if (R_ < 256) { r_ = R_ & 31; rows_ = 32; bs_ = (R_ >> 5) * 2048; } else { const int R2_ = R_ - 256; r_ = R2_ & 255; rows_ = 256; bs_ = NPT + (R2_ >> 8) * 16384; } \
        rs_ = min(max(r_ - 4, 0), rows_ - 8); }
        int pbs = -1, prs = 0, ph = -1, nkind = 2;
        float bvs[4][8]; int pbk = -1;
#pragma unroll
        for (int a_ = 0; a_ < 4; ++a_)
#pragma unroll
            for (int b_ = 0; b_ < 8; ++b_) bvs[a_][b_] = 0.f;
#define NA_KIND(h_, bs_, rs_) (((bs_) == pbs && (h_) == ph) ? ((rs_) == prs ? 0 : ((rs_) == prs + 1 ? 1 : 2)) : 2)
#define NA_ISSUE(kind_, h_, r_, bs_, rs_) do { \
        if ((kind_) == 1) { const int tb_ = bs_ + (rs_ + 7) * 64; \
            stK0 = *(const u32x4*)(Z + (size_t)(tb_ + (tid >> 3)) * ZW + 1792 + h_ * 64 + (tid & 7) * 8); \
            stV0 = *(const u32x4*)(ZT + (size_t)(512 + h_ * 64 + (tid >> 3)) * MTOK + tb_ + (tid & 7) * 8); } \
        const bf16_t* zq_ = Z + (size_t)(bs_ + r_ * 64 + qc) * ZW; \
        _Pragma("unroll") for (int ks = 0; ks < 2; ++ks) qn[ks] = *(const bf16x8*)(zq_ + 768 + h_ * 64 + ks * 32 + quad * 8); \
        _Pragma("unroll") for (int mt = 0; mt < 4; ++mt) ggn[mt] = *(const u32x2*)(zq_ + 2048 + h_ * 64 + mt * 16 + quad * 4); \
        pbs = bs_; prs = rs_; ph = h_; } while (0)
        if (jbeg < jend) { NA_DECODE(jbeg, h0, r0, bs0, rs0); NA_ISSUE(2, h0, r0, bs0, rs0); }
#pragma unroll 1
        for (int j = jbeg; j < jend; ++j) {
            NA_DECODE(j, h, r, bs, rs);
            const int kind = nkind;
            if (kind == 2) {
                const int tb = bs + rs * 64; u32x4 fk[8], fv[8];
#pragma unroll
                for (int i = 0; i < 8; ++i) { const int idx = tid + 512 * i;
                    fk[i] = *(const u32x4*)(Z + (size_t)(tb + (idx >> 3)) * ZW + 1792 + h * 64 + (idx & 7) * 8);
                    fv[i] = *(const u32x4*)(ZT + (size_t)(512 + h * 64 + (idx >> 6)) * MTOK + tb + (idx & 63) * 8); }
#pragma unroll
                for (int i = 0; i < 8; ++i) { const int idx = tid + 512 * i;
                    *(LAS u32x4*)(lds + NAK_OFF + ((((rs + (idx >> 9)) & 7) * 64) + ((idx >> 3) & 63)) * NAKP + (idx & 7) * 16) = fk[i];
                    *(LAS u32x4*)(lds + NAV_OFF + (idx >> 6) * NAVP + ((((rs + ((idx & 63) >> 3)) & 7) * 64) + (idx & 7) * 8) * 2) = fv[i]; }
            } else if (kind == 1) {
                const int sl = (rs + 7) & 7;
                *(LAS u32x4*)(lds + NAK_OFF + (sl * 64 + (tid >> 3)) * NAKP + (tid & 7) * 16) = stK0;
                *(LAS u32x4*)(lds + NAV_OFF + (tid >> 3) * NAVP + (sl * 64 + (tid & 7) * 8) * 2) = stV0;
            }
            bf16x8 qf[2]; u32x2 gg[4];
#pragma unroll
            for (int ks = 0; ks < 2; ++ks) qf[ks] = qn[ks];
#pragma unroll
            for (int mt = 0; mt < 4; ++mt) gg[mt] = ggn[mt];
            __syncthreads();
            { const int jn = min(j + 1, jend - 1); NA_DECODE(jn, hn, rn, bsn, rsn); nkind = NA_KIND(hn, bsn, rsn); NA_ISSUE(nkind, hn, rn, bsn, rsn); }
            __builtin_amdgcn_sched_barrier(0);
            f32x4 s[8];
            {
                bf16x8 kfr[8][2];
#pragma unroll
                for (int w4 = 0; w4 < 4; ++w4)
#pragma unroll
                    for (int hf = 0; hf < 2; ++hf) {
                        const int key = ((rs + half * 4 + w4) & 7) * 64 + c0 + 8 * (fr >> 2) + (fr & 3) + 4 * hf;
                        const LAS unsigned char* ka = lds + NAK_OFF + key * NAKP + quad * 16;
                        kfr[w4 * 2 + hf][0] = *(const LAS bf16x8*)ka; kfr[w4 * 2 + hf][1] = *(const LAS bf16x8*)(ka + 64);
                    }
                __builtin_amdgcn_sched_barrier(0);
#pragma unroll
                for (int nt = 0; nt < 8; ++nt) { const f32x4 t = mma_bf16(kfr[nt][0], qf[0], (f32x4){0.f, 0.f, 0.f, 0.f}); s[nt] = mma_bf16(kfr[nt][1], qf[1], t); }
            }
            { const int bk = h * 64 + (rs - r + 16);
              if (bk != pbk) { pbk = bk;
                const LAS float* rp = rpb + h * 465;
#pragma unroll
                for (int w4 = 0; w4 < 4; ++w4) {
                    const int dr = rs + half * 4 + w4 - r + 7;
#pragma unroll
                    for (int hf = 0; hf < 2; ++hf)
#pragma unroll
                        for (int jj = 0; jj < 4; ++jj) {
                            const int kc = c0 + 8 * quad + 4 * hf + jj;
                            const bool valid = (kc >= cst) && (kc < cst + 16);
                            bvs[w4][hf * 4 + jj] = rp[valid ? dr * 31 + (kc - qc + 15) : 0];
                        }
                    asm volatile("" : "+v"(bvs[w4][0]), "+v"(bvs[w4][1]), "+v"(bvs[w4][2]), "+v"(bvs[w4][3]), "+v"(bvs[w4][4]), "+v"(bvs[w4][5]), "+v"(bvs[w4][6]), "+v"(bvs[w4][7]));
                } } }
            float mx = -INFINITY;
#pragma unroll
            for (int w4 = 0; w4 < 4; ++w4)
#pragma unroll
                for (int hf = 0; hf < 2; ++hf)
#pragma unroll
                    for (int jj = 0; jj < 4; ++jj) {
                        const int kc = c0 + 8 * quad + 4 * hf + jj;
                        const bool valid = (kc >= cst) && (kc < cst + 16);
                        const float v = valid ? s[w4 * 2 + hf][jj] * 0.18033688011f + bvs[w4][hf * 4 + jj] : -INFINITY;
                        s[w4 * 2 + hf][jj] = v; mx = fmaxf(mx, v);
                    }
            mx = quad_max(mx);
            float lsum = 0.f;
#pragma unroll
            for (int nt = 0; nt < 8; ++nt)
#pragma unroll
                for (int jj = 0; jj < 4; ++jj) { const float pe = __builtin_amdgcn_exp2f(s[nt][jj] - mx); s[nt][jj] = pe; lsum += pe; }
            lsum = quad_sum(lsum);
            f32x4 o[4];
#pragma unroll
            for (int mt = 0; mt < 4; ++mt) o[mt] = (f32x4){0.f, 0.f, 0.f, 0.f};
#pragma unroll
            for (int wb = 0; wb < 2; ++wb) {
                bf16x8 vfr[2][4];
#pragma unroll
                for (int wi = 0; wi < 2; ++wi)
#pragma unroll
                    for (int mt = 0; mt < 4; ++mt) vfr[wi][mt] = *(const LAS bf16x8*)(lds + NAV_OFF + (mt * 16 + fr) * NAVP + (((rs + half * 4 + wb * 2 + wi) & 7) * 64 + c0 + 8 * quad) * 2);
                __builtin_amdgcn_sched_barrier(0);
#pragma unroll
                for (int wi = 0; wi < 2; ++wi) { const int w4 = wb * 2 + wi;
                    u32x4 pw; pw.x = cvt_pk_bf16(s[2 * w4][0], s[2 * w4][1]); pw.y = cvt_pk_bf16(s[2 * w4][2], s[2 * w4][3]); pw.z = cvt_pk_bf16(s[2 * w4 + 1][0], s[2 * w4 + 1][1]); pw.w = cvt_pk_bf16(s[2 * w4 + 1][2], s[2 * w4 + 1][3]);
                    const bf16x8 pf = __builtin_bit_cast(bf16x8, pw);
#pragma unroll
                    for (int mt = 0; mt < 4; ++mt) o[mt] = mma_bf16(vfr[wi][mt], pf, o[mt]); }
            }
            LAS unsigned* ex = (LAS unsigned*)(lds + NAEX_OFF) + cb * 640 + lane;
            if (half == 1) {
                ex[0] = __float_as_uint(mx); ex[64] = __float_as_uint(lsum);
#pragma unroll
                for (int mt = 0; mt < 4; ++mt) { ex[(2 + 2 * mt) * 64] = pkh(o[mt][0], o[mt][1]); ex[(3 + 2 * mt) * 64] = pkh(o[mt][2], o[mt][3]); }
            }
            __syncthreads();
            if (half == 0) {
                const float m1 = __uint_as_float(ex[0]), l1 = __uint_as_float(ex[64]);
                const float m = fmaxf(mx, m1), a0 = __builtin_amdgcn_exp2f(mx - m), a1 = __builtin_amdgcn_exp2f(m1 - m);
                const float inv = 1.f / (lsum * a0 + l1 * a1);
                bf16_t* zr = Z + (size_t)(bs + r * 64 + qc) * ZW;
#pragma unroll
                for (int mt = 0; mt < 4; ++mt) {
                    const f16x2 p01 = __builtin_bit_cast(f16x2, ex[(2 + 2 * mt) * 64]), p23 = __builtin_bit_cast(f16x2, ex[(3 + 2 * mt) * 64]);
                    const float y0 = (o[mt][0] * a0 + (float)p01.x * a1) * inv, y1 = (o[mt][1] * a0 + (float)p01.y * a1) * inv;
                    const float y2 = (o[mt][2] * a0 + (float)p23.x * a1) * inv, y3 = (o[mt][3] * a0 + (float)p23.y * a1) * inv;
                    const int dcol = h * 64 + mt * 16 + quad * 4;
                    u32x2 w; w.x = cvt_pk_bf16(y0 * bf2f(gg[mt].x & 0xffffu), y1 * __uint_as_float(gg[mt].x & 0xffff0000u));
                    w.y = cvt_pk_bf16(y2 * bf2f(gg[mt].y & 0xffffu), y3 * __uint_as_float(gg[mt].y & 0xffff0000u));
                    if (mode & 8) *(u32x2*)(DUM + (size_t)(bs + r * 64 + qc) * 256 + dcol) = w; else *(u32x2*)(zr + 768 + dcol) = w;
                }
            }
        }
#undef NA_DECODE
#undef NA_ISSUE
#undef NA_KIND
    }
    __syncthreads();
    if (mode & 4) {
        const u16* YT = (const u16*)(ws + WS_ZT);
        LAS unsigned char* T = lds + wave * 8448;
        const int vcu_t = (G % 8 == 0) ? (bid % 8) * (G / 8) + bid / 8 : bid;
        for (int it = G - 1 - vcu_t; it < 384; it += G) {
            const int tile = it * 8 + wave, tb = tile >> 2, cbk = tile & 3;
            u32x4 yv[8], gv8[8];
#pragma unroll
            for (int i = 0; i < 8; ++i) { const int ch = i * 8 + (lane >> 3), k8 = lane & 7; yv[i] = *(const u32x4*)(YT + (size_t)(cbk * 64 + ch) * MTOK + tb * 64 + k8 * 8); }
#pragma unroll
            for (int i = 0; i < 8; ++i) { const int tok = i * 8 + (lane >> 3), c8 = lane & 7; gv8[i] = *(const u32x4*)(Z + (size_t)(tb * 64 + tok) * ZW + 512 + cbk * 64 + c8 * 8); }
            __builtin_amdgcn_sched_barrier(0);
#pragma unroll
            for (int i = 0; i < 8; ++i) {
                const int ch = i * 8 + (lane >> 3), k8 = lane & 7;
                LAS unsigned* d = (LAS unsigned*)(T + ch * 132 + k8 * 16);
                d[0] = yv[i].x; d[1] = yv[i].y; d[2] = yv[i].z; d[3] = yv[i].w;
            }
            asm volatile("s_waitcnt lgkmcnt(0)" ::: "memory");
#pragma unroll
            for (int i = 0; i < 8; ++i) {
                const int tok = i * 8 + (lane >> 3), c8 = lane & 7;
                bf16_t* gp = Z + (size_t)(tb * 64 + tok) * ZW + 512 + cbk * 64 + c8 * 8;
                float gt[8]; unpack8(gv8[i], gt);
                float y[8];
#pragma unroll
                for (int e = 0; e < 8; ++e) y[e] = (float)*(const LAS _Float16*)(T + (c8 * 8 + e) * 132 + tok * 2) * gt[e];
                u32x4 w; w.x = cvt_pk_bf16(y[0], y[1]); w.y = cvt_pk_bf16(y[2], y[3]); w.z = cvt_pk_bf16(y[4], y[5]); w.w = cvt_pk_bf16(y[6], y[7]);
                if (mode & 8) *(u32x4*)(DUM + (size_t)(tb * 64 + tok) * 256 + cbk * 64 + c8 * 8) = w; else *(u32x4*)gp = w;
            }
            asm volatile("s_waitcnt lgkmcnt(0)" ::: "memory");
        }
    }
    if ((mode & 16) && l + 1 < NLAYER) gen_w16(p, ws, l + 1, bid * NTHR + tid, G * NTHR);
}

#define XB_TMO      128
#define XB_XCNT(j)  (256  + 64 * (j))
#define XB_XSUB(j)  (1280 + 64 * (j))
#define XB_XGEN(j)  (2304 + 64 * (j))
#define XB_TOP      3328
#define XB_TOPGEN   3392
#define XCD_BAR_WORDS 3456
#define XB_SPIN_CAP (1u << 18)

__device__ __forceinline__ unsigned xb_ld(unsigned* p)              { return __hip_atomic_load(p, __ATOMIC_RELAXED, __HIP_MEMORY_SCOPE_AGENT); }
__device__ __forceinline__ unsigned xb_add(unsigned* p, unsigned v) { return __hip_atomic_fetch_add(p, v, __ATOMIC_RELAXED, __HIP_MEMORY_SCOPE_AGENT); }
__device__ __forceinline__ unsigned xb_xcc_id() { return (unsigned)__builtin_amdgcn_s_getreg((3 << 11) | 20) & 0xFu; }
#define XB_SPIN(cond, bar) do { unsigned _sp = 0; while (cond) { __builtin_amdgcn_s_sleep(1); \
    if ((++_sp & 255u) == 0u) { if (xb_ld(&(bar)[XB_TMO])) break; if (_sp > XB_SPIN_CAP) { atomicAdd(&(bar)[XB_TMO], 1u); break; } } } } while (0)

struct XcdBarrier {
    unsigned* bar; unsigned x;
    volatile LAS unsigned* st;
};

__device__ __forceinline__ XcdBarrier xcd_barrier_post(unsigned* bar, volatile LAS unsigned* st) {
    XcdBarrier b; b.bar = bar; b.x = xb_xcc_id(); b.st = st;
    if (threadIdx.x == 0) (void)xb_add(&bar[XB_XCNT(b.x)], 1u);
    return b;
}
__device__ __forceinline__ void xcd_barrier_complete(unsigned* bar, unsigned x, unsigned& nloc, unsigned& nx) {
    const unsigned G = gridDim.x * gridDim.y * gridDim.z;
    unsigned sum, cnt, mine, sp = 0u;
    for (;;) {
        sum = 0u; cnt = 0u; mine = 0u;
#pragma unroll
        for (unsigned j = 0; j < 16; ++j) { const unsigned c = xb_ld(&bar[XB_XCNT(j)]); sum += c; cnt += (c > 0u) ? 1u : 0u; mine = (j == x) ? c : mine; }
        if (sum == G) break;
        __builtin_amdgcn_s_sleep(1);
        if ((++sp & 255u) == 0u) { if (xb_ld(&bar[XB_TMO])) break; if (sp > XB_SPIN_CAP) { atomicAdd(&bar[XB_TMO], 1u); break; } }
    }
    nloc = mine > 0u ? mine : 1u; nx = cnt > 0u ? cnt : 1u;
}

__device__ __forceinline__ void xcd_barrier(const XcdBarrier& b) {
    asm volatile("s_waitcnt vmcnt(0)" ::: "memory");
    __syncthreads();
    if (threadIdx.x == 0) {
        unsigned* bar = b.bar;
        __builtin_amdgcn_s_waitcnt(0);
        unsigned nloc = b.st[0], nx = b.st[1];
        if (nloc == 0u) { xcd_barrier_complete(bar, b.x, nloc, nx); b.st[0] = nloc; b.st[1] = nx; }
        const unsigned old = xb_add(&bar[XB_XSUB(b.x)], 1u);
        const unsigned gen = old / nloc;
        if (old + 1u == (gen + 1u) * nloc) {
            __builtin_amdgcn_fence(__ATOMIC_RELEASE, "agent");
            asm volatile("s_waitcnt vmcnt(0)" ::: "memory");
            const unsigned og = xb_add(&bar[XB_TOP], 1u);
            const unsigned tg = og / nx;
            if (og + 1u == (tg + 1u) * nx) xb_add(&bar[XB_TOPGEN], 1u);
            else XB_SPIN(xb_ld(&bar[XB_TOPGEN]) == tg, bar);
            __builtin_amdgcn_fence(__ATOMIC_ACQUIRE, "agent");
            xb_add(&bar[XB_XGEN(b.x)], 1u);
            asm volatile("s_waitcnt vmcnt(0)" ::: "memory");
        } else {
            XB_SPIN(xb_ld(&bar[XB_XGEN(b.x)]) == gen, bar);
            __builtin_amdgcn_fence(__ATOMIC_ACQUIRE, "agent");
            asm volatile("s_waitcnt vmcnt(0)" ::: "memory");
        }
    }
    __syncthreads();
}

#ifndef PHM
#define PHM 127
#endif
#ifndef DUP
#define DUP 0
#endif
__global__ void __launch_bounds__(NTHR, 2) hpge_fwd(Params p) {
    extern __shared__ __attribute__((aligned(16))) unsigned char lds_raw[];
    LAS unsigned char* lds = (LAS unsigned char*)lds_raw;
    const int tid = threadIdx.x, lane = tid & 63, wave = __builtin_amdgcn_readfirstlane(tid >> 6);
    const int bid = blockIdx.x, G = gridDim.x;
    unsigned char* ws = p.ws;
    const int lo = p.ph_lo, hi = p.ph_hi;
    const bool coop = (hi - lo) > 1;
#define IN(k) (lo <= (k) && (k) < hi)
    volatile LAS unsigned* MISC = (volatile LAS unsigned*)(lds + LDS_BYTES - 64);
    if (tid < 16) MISC[tid] = 0u;
    __syncthreads();
    XcdBarrier bar; bar.bar = (unsigned*)ws; bar.x = 0; bar.st = nullptr;
    if (coop) bar = xcd_barrier_post((unsigned*)ws, MISC);
    if (hi > NPHASE) { __threadfence(); cg::this_grid().sync(); }
#define SEAM(k) do { if (coop && IN(k) && IN((k) + 1)) { xcd_barrier(bar); if (DUP & 1) xcd_barrier(bar); } } while (0)
    if (IN(0) && (PHM & 1)) { phase_p0a(p, lds, bid, G, tid, lane, wave); if (DUP & 2) { __syncthreads(); phase_p0a(p, lds, bid, G, tid, lane, wave); } }
    SEAM(0);
    if (IN(1) && (PHM & 2)) { phase_p0b(p, lds, bid, G, tid, lane, wave); if (DUP & 512) { __syncthreads(); phase_p0b(p, lds, bid, G, tid, lane, wave); } }
    SEAM(1);
#pragma unroll 1
    for (int l = 0; l < NLAYER; ++l) {
        const int pb = 2 + 4 * l;
        if (IN(pb) && (PHM & 4)) {
            __syncthreads();
            pg8::Gemm g{(const bf16_t*)(ws + WS_X16), (const bf16_t*)(ws + WS_W16), MTOK, NIN, D, D, D, 0xE00u, (size_t)NIN * D * 2};
            pg8::StaticOrder S; S.init(MTOK, NIN, G, bid);
            Epi1 E{(bf16_t*)(ws + WS_Z), (u16*)(ws + WS_ZT), (const float*)(ws + WS_SSQ), (const float*)(ws + WS_SB) + (size_t)l * NB * NIN, 0};
            if (DUP & 4) { E.noact = 2; pg8::gemm_phase<Epi1, pg8::StaticOrder, true, true, true>(lds, g, S, E); E.noact = 0; __syncthreads(); xcd_barrier(bar); }
            pg8::gemm_phase<Epi1, pg8::StaticOrder, true, true, true>(lds, g, S, E);
        }
        SEAM(pb);
        if (IN(pb + 1) && (PHM & 8)) { phase_p2a(p, lds, bid, G, tid, lane, wave); if (DUP & 8) phase_p2a(p, lds, bid, G, tid, lane, wave, 1); if (DUP & 16) phase_p2a(p, lds, bid, G, tid, lane, wave, 6); }
        SEAM(pb + 1);
        if (IN(pb + 2) && (PHM & 16)) { phase_p2b(p, lds, l, bid, G, tid, lane, wave); if (DUP & 32) phase_p2b(p, lds, l, bid, G, tid, lane, wave, 9); if (DUP & 64) phase_p2b(p, lds, l, bid, G, tid, lane, wave, 10); if (DUP & 128) phase_p2b(p, lds, l, bid, G, tid, lane, wave, 12); }
        SEAM(pb + 2);
        if (IN(pb + 3) && (PHM & 32)) {
            __syncthreads();
            pg8::Gemm g{(const bf16_t*)(ws + WS_Z), (const bf16_t*)(ws + WS_WOUT) + (size_t)l * D * D, MTOK, D, D, ZW, D, 0u, 0};
            pg8::StaticOrder S; S.init(MTOK, D, G, bid);
            Epi2 E{(u16*)(ws + WS_X16), (float*)(ws + WS_SSQ), (const float*)(ws + WS_MOD) + (size_t)l * NB * 3072 + 2048, 1.f};
            if (DUP & 1024) { E.gscale = 0.f; E.ssq = (float*)(ws + WS_END); pg8::gemm_phase<Epi2, pg8::StaticOrder, true, true>(lds, g, S, E); E.gscale = 1.f; E.ssq = (float*)(ws + WS_SSQ); __syncthreads(); }
            pg8::gemm_phase<Epi2, pg8::StaticOrder, true, true>(lds, g, S, E);
            if (l + 1 < NLAYER) gen_w16(p, ws, l + 1, bid * NTHR + tid, G * NTHR);
        }
        SEAM(pb + 3);
    }
    if (IN(NPHASE - 1) && (PHM & 64)) { phase_final(p, bid, G, lane, wave); }
#undef IN
#undef SEAM
}

#ifndef HPGE_MULTI
#define HPGE_MULTI 0
#endif
extern "C" void kernel_launch(void* const* d_in, const int* in_sizes, int n_in, void* d_out, int out_size, void* d_ws, size_t ws_size, hipStream_t stream) {
    static int grid = 0;
    if (grid == 0) {
        if (n_in != 17 || out_size != MTOK * D || ws_size < WS_END) { fprintf(stderr, "kernel_launch: unexpected shapes (n_in %d out %d ws %zu)\n", n_in, out_size, ws_size); grid = -1; return; }
        int dev = 0, cus = 0, per_cu = 0;
        (void)hipGetDevice(&dev); (void)hipDeviceGetAttribute(&cus, hipDeviceAttributeMultiprocessorCount, dev);
        if (hipFuncSetAttribute((const void*)hpge_fwd, hipFuncAttributeMaxDynamicSharedMemorySize, LDS_BYTES) != hipSuccess) { fprintf(stderr, "kernel_launch: hipFuncSetAttribute failed\n"); grid = -1; return; }
        if (hipOccupancyMaxActiveBlocksPerMultiprocessor(&per_cu, (const void*)hpge_fwd, NTHR, LDS_BYTES) != hipSuccess || per_cu < 1) { fprintf(stderr, "kernel_launch: occupancy query gave %d\n", per_cu); per_cu = 1; }
        (void)hipGetLastError();
        grid = cus * (per_cu > 1 ? 1 : per_cu);
        if (grid <= 0) grid = 256;
    }
    if (grid < 0) return;
    if (hipMemsetAsync(d_ws, 0, 16384, stream) != hipSuccess) { fprintf(stderr, "kernel_launch: memset failed\n"); return; }
    Params p{};
    for (int i = 0; i < 17; ++i) p.in[i] = (const float*)d_in[i];
    p.out = (float*)d_out; p.ws = (unsigned char*)d_ws;
#if HPGE_MULTI
    for (int k = 0; k < NPHASE; ++k) { p.ph_lo = k; p.ph_hi = k + 1; hipLaunchKernelGGL(hpge_fwd, dim3(grid), dim3(NTHR), LDS_BYTES, stream, p); }
#else
    p.ph_lo = 0; p.ph_hi = NPHASE;
    void* args[] = {&p};
    const hipError_t e = hipLaunchCooperativeKernel((const void*)hpge_fwd, dim3(grid), dim3(NTHR), args, LDS_BYTES, stream);
    if (e != hipSuccess) fprintf(stderr, "kernel_launch: cooperative launch failed: %s (grid %d)\n", hipGetErrorString(e), grid);
#endif
}
```

```cpp
#include <hip/hip_runtime.h>
#include <hip/hip_cooperative_groups.h>
#include <cstdio>
#include <cstdint>
namespace cg = cooperative_groups;
namespace pg8 {
#define PG8_LAS __attribute__((address_space(3)))
typedef unsigned short bf16_t;
typedef short bf16x8 __attribute__((ext_vector_type(8)));
typedef float f32x4 __attribute__((ext_vector_type(4)));
typedef unsigned u32x4 __attribute__((ext_vector_type(4)));
constexpr int BM = 256, BK = 64, HALF = 128, HTB = HALF * BK * 2  , STAGE_BYTES = 8 * HTB, NXCD = 8, WGM = 8;

__host__ __device__ __forceinline__ int lds_byte(int r, int c) { const int st = (r >> 4) * 2 + (c >> 5), rr = r & 15, cc = c & 31, ob = rr * 64 + cc * 2; return st * 1024 + (ob ^ (((ob >> 9) & 1) << 5)); }
__host__ __device__ __forceinline__ void stage_rc(int b, int& R, int& C) { const int st = b / 1024, sb = b % 1024, swz = sb ^ (((sb >> 9) & 1) << 5); R = (st >> 1) * 16 + swz / 64; C = (st & 1) * 32 + (swz % 64) / 2; }
__host__ __device__ __forceinline__ int perm32(int rho) { const int n = rho >> 4, i = rho & 15; return 8 * (i >> 2) + 4 * n + (i & 3); }

struct Unit { int pm, pn; };
struct Gemm { const bf16_t* A; const bf16_t* Bt; int M, N, K, ldA, ldB; unsigned tmask; size_t bstride; };
__device__ __forceinline__ void unit_ptrs(const Gemm& g, const Unit& u, size_t tsA, size_t tsB, const char*& a, const char*& b) {
    const int bt = u.pm < 64 ? (u.pm >> 3) : 8 + ((u.pm - 64) >> 6);
    const char* w = (const char*)g.Bt + (size_t)bt * g.bstride + (size_t)u.pn * tsB;
    if ((g.tmask >> u.pn) & 1u) { a = w; b = (const char*)g.A + (size_t)u.pm * tsA; }
    else { a = (const char*)g.A + (size_t)u.pm * tsA; b = w; }
}
typedef _Float16 f16x8_t __attribute__((ext_vector_type(8)));
template <bool F16> __device__ __forceinline__ f32x4 mma16(bf16x8 a, bf16x8 b, f32x4 c) {
    if constexpr (F16) return __builtin_amdgcn_mfma_f32_16x16x32_f16(__builtin_bit_cast(f16x8_t, a), __builtin_bit_cast(f16x8_t, b), c, 0, 0, 0);
    else return __builtin_amdgcn_mfma_f32_16x16x32_bf16(a, b, c, 0, 0, 0);
}

struct StaticOrder {
    int nM, nN, nwg, G, c;
    __host__ __device__ void init(int M, int N, int G_, int c_) { nM = M / BM; nN = N / BM; nwg = nM * nN; G = G_; c = c_; }
    __host__ __device__ bool next(int i, Unit& u) const {
        const long L = (long)i * G + c; if (L >= nwg) return false;
        int wgid = (int)L; { const int q = nwg / NXCD, r = nwg % NXCD, xcd = wgid % NXCD, off = wgid / NXCD; wgid = (xcd < r ? xcd * (q + 1) : r * (q + 1) + (xcd - r) * q) + off; }
        const int nig = WGM * nN, gid = wgid / nig, fm = gid * WGM, gsz = (nM - fm) < WGM ? (nM - fm) : WGM;
        u.pm = fm + ((wgid % nig) % gsz); u.pn = (wgid % nig) / gsz; return true;
    }
    __device__ __forceinline__ void a_ready(const Unit&) const {}
    __device__ __forceinline__ void done(const Unit&) const {}
};
typedef float f32x2_t __attribute__((ext_vector_type(2))); typedef __bf16 bf16x2_t __attribute__((ext_vector_type(2)));
__device__ __forceinline__ unsigned cvt_pk_bf16(float lo, float hi) { f32x2_t v = {lo, hi}; bf16x2_t b = __builtin_convertvector(v, bf16x2_t); return __builtin_bit_cast(unsigned, b); }

template <class Epi, class Sched, bool ALIGN_EPI = false, bool SP2 = false, bool F16 = false>
__device__ __forceinline__ void gemm_phase(PG8_LAS unsigned char* lds, const Gemm g, const Sched& S, const Epi& E) {
    int tid = threadIdx.x; asm volatile("" : "+v"(tid));
    const int wid = __builtin_amdgcn_readfirstlane(tid >> 6), lane = tid & 63, wr = wid >> 2, wc = wid & 3, fr = lane & 15, fq = lane >> 4;
    const int K = g.K, nt = K / BK;
    unsigned voffA[2], voffB[2];
#pragma unroll
    for (int i = 0; i < 2; ++i) { int R, C; stage_rc(tid * 16 + i * 8192, R, C); const int Rb = Epi::PERM ? ((R & ~31) + perm32(R & 31)) : R;
        voffA[i] = (unsigned)(R * g.ldA + C) * 2u; voffB[i] = (unsigned)(Rb * g.ldB + C) * 2u; }
    const size_t kstep = (size_t)(BK * 2);
    const size_t hsA = (size_t)HALF * g.ldA * 2, hsB = (size_t)HALF * g.ldB * 2;
    const size_t tsA = 2 * hsA, tsB = 2 * hsB;
    const unsigned ldsw = (unsigned)wid * 1024u;
    const int aoff = lds_byte(wr * 64 + fr, fq * 8), boff = lds_byte(wc * 32 + fr, fq * 8);
#define PG8_SA(b, h) (((b) * 2 + (h)) * HTB)
#define PG8_SB(b, h) ((4 + (b) * 2 + (h)) * HTB)
#define PG8_STAGE(bufoff, gbase, voff) do { _Pragma("unroll") for (int _i = 0; _i < 2; ++_i) \
        __builtin_amdgcn_global_load_lds((const unsigned*)((const char*)(gbase) + (voff)[_i]), (PG8_LAS unsigned*)(lds + (bufoff) + ldsw + _i * 8192), 16, 0, 0); } while (0)
#define PG8_LDA(dst, b, h) do { _Pragma("unroll") for (int m = 0; m < 4; ++m) _Pragma("unroll") for (int k = 0; k < 2; ++k) dst[m][k] = *(const PG8_LAS bf16x8*)(lds + PG8_SA(b, h) + aoff + m * 2048 + k * 1024); } while (0)
#define PG8_LDB(dst, b, h) do { _Pragma("unroll") for (int n = 0; n < 2; ++n) _Pragma("unroll") for (int k = 0; k < 2; ++k) dst[n][k] = *(const PG8_LAS bf16x8*)(lds + PG8_SB(b, h) + boff + n * 2048 + k * 1024); } while (0)
#define PG8_MMA(ai, bj, At, Bt) do { __builtin_amdgcn_s_setprio(1); _Pragma("unroll") for (int m = 0; m < 4; ++m) _Pragma("unroll") for (int n = 0; n < 2; ++n) _Pragma("unroll") for (int k = 0; k < 2; ++k) \
        acc[ai][bj][m][n] = mma16<F16>(Bt[n][k], At[m][k], acc[ai][bj][m][n]); __builtin_amdgcn_s_setprio(0); } while (0)
#define PG8_WAIT_V(n) asm volatile("s_waitcnt vmcnt(" #n ")" ::: "memory")
#define PG8_WAIT_L(n) asm volatile("s_waitcnt lgkmcnt(" #n ")" ::: "memory")
#define PG8_BAR __builtin_amdgcn_s_barrier()
#define PG8_SCHED __builtin_amdgcn_sched_barrier(0)
    Unit cur, nxt; int ui = 0;
    typename Epi::Pre pre;
    if (!S.next(0, cur)) return;
    f32x4 acc[2][2][4][2];
#pragma unroll
    for (int a = 0; a < 2; ++a)
#pragma unroll
        for (int b = 0; b < 2; ++b)
#pragma unroll
            for (int m = 0; m < 4; ++m)
#pragma unroll
                for (int n = 0; n < 2; ++n) acc[a][b][m][n] = (f32x4){0.f, 0.f, 0.f, 0.f};
    bf16x8 At[4][2], B0[2][2], B1[2][2];
    const char* cA; const char* cB; unit_ptrs(g, cur, tsA, tsB, cA, cB);
    S.a_ready(cur);
    if constexpr (SP2) {
        PG8_STAGE(PG8_SB(0, 0), cB, voffB); PG8_STAGE(PG8_SB(0, 1), cB + hsB, voffB); PG8_STAGE(PG8_SA(0, 0), cA, voffA); PG8_STAGE(PG8_SA(0, 1), cA + hsA, voffA);
        if (wr == 1) PG8_BAR;
        PG8_WAIT_V(2); PG8_BAR;
        PG8_STAGE(PG8_SB(1, 0), cB + kstep, voffB); PG8_STAGE(PG8_SA(1, 0), cA + kstep, voffA); PG8_STAGE(PG8_SB(1, 1), cB + hsB + kstep, voffB);
        PG8_WAIT_V(6); PG8_BAR;
    } else {
        PG8_STAGE(PG8_SB(0, 0), cB, voffB); PG8_STAGE(PG8_SA(0, 0), cA, voffA); PG8_STAGE(PG8_SB(0, 1), cB + hsB, voffB); PG8_STAGE(PG8_SA(0, 1), cA + hsA, voffA);
        if (wr == 1) PG8_BAR;
        PG8_WAIT_V(4); PG8_BAR;
        PG8_STAGE(PG8_SB(1, 0), cB + kstep, voffB); PG8_STAGE(PG8_SA(1, 0), cA + kstep, voffA); PG8_STAGE(PG8_SB(1, 1), cB + hsB + kstep, voffB);
        PG8_WAIT_V(6); PG8_BAR;
    }
    for (;;) {
        const bool has_next = S.next(ui + 1, nxt);
        const char* nA = cA; const char* nB = cB; if (has_next) unit_ptrs(g, nxt, tsA, tsB, nA, nB);
        for (int t = 0; t < nt; t += 2) {
            const bool last = (t == nt - 2);
            const char* a1 = cA + (size_t)(t + 1) * kstep;
            const char* a2 = last ? nA : cA + (size_t)(t + 2) * kstep; const char* b2 = last ? nB : cB + (size_t)(t + 2) * kstep;
            const char* a3 = a2 + kstep; const char* b3 = b2 + kstep;
            if (last && has_next) S.a_ready(nxt);
            if (last) E.prefetch(pre, cur, wr, wc, fr, fq);
            if constexpr (SP2) {
            PG8_LDB(B0, 0, 0); PG8_LDB(B1, 0, 1); PG8_SCHED; PG8_LDA(At, 0, 0); PG8_STAGE(PG8_SA(1, 1), a1 + hsA, voffA);
            PG8_WAIT_V(8); PG8_WAIT_L(0); PG8_BAR; PG8_MMA(0, 0, At, B0); PG8_MMA(0, 1, At, B1); PG8_BAR; PG8_SCHED;
            PG8_LDA(At, 0, 1); PG8_STAGE(PG8_SB(0, 0), b2, voffB); PG8_STAGE(PG8_SB(0, 1), b2 + hsB, voffB); PG8_STAGE(PG8_SA(0, 0), a2, voffA);
            PG8_WAIT_V(8); PG8_WAIT_L(0); PG8_BAR; PG8_MMA(1, 0, At, B0); PG8_MMA(1, 1, At, B1); PG8_BAR; PG8_SCHED;
            PG8_LDB(B0, 1, 0); PG8_LDB(B1, 1, 1); PG8_SCHED; PG8_LDA(At, 1, 0); PG8_STAGE(PG8_SA(0, 1), a2 + hsA, voffA);
            PG8_WAIT_V(8); PG8_WAIT_L(0); PG8_BAR; PG8_MMA(0, 0, At, B0); PG8_MMA(0, 1, At, B1); PG8_BAR; PG8_SCHED;
            PG8_LDA(At, 1, 1); PG8_STAGE(PG8_SB(1, 0), b3, voffB); PG8_STAGE(PG8_SB(1, 1), b3 + hsB, voffB); PG8_STAGE(PG8_SA(1, 0), a3, voffA);
            PG8_WAIT_V(8); PG8_WAIT_L(0); PG8_BAR; PG8_MMA(1, 0, At, B0); PG8_MMA(1, 1, At, B1); PG8_BAR; PG8_SCHED;
            } else {
            PG8_LDB(B0, 0, 0); PG8_SCHED; PG8_LDA(At, 0, 0); PG8_STAGE(PG8_SA(1, 1), a1 + hsA, voffA);
            PG8_WAIT_L(8); PG8_BAR; PG8_WAIT_L(0); PG8_MMA(0, 0, At, B0); PG8_BAR; PG8_SCHED;
            PG8_LDB(B1, 0, 1); PG8_STAGE(PG8_SB(0, 0), b2, voffB);
            PG8_BAR; PG8_WAIT_L(0); PG8_MMA(0, 1, At, B1); PG8_BAR;
            PG8_LDA(At, 0, 1); PG8_STAGE(PG8_SA(0, 0), a2, voffA);
            PG8_BAR; PG8_WAIT_L(0); PG8_MMA(1, 0, At, B0); PG8_BAR; PG8_SCHED;
            PG8_STAGE(PG8_SB(0, 1), b2 + hsB, voffB);
            PG8_WAIT_V(6); PG8_BAR; PG8_MMA(1, 1, At, B1); PG8_BAR;
            PG8_LDB(B0, 1, 0); PG8_SCHED; PG8_LDA(At, 1, 0); PG8_STAGE(PG8_SA(0, 1), a2 + hsA, voffA);
            PG8_WAIT_L(8); PG8_BAR; PG8_WAIT_L(0); PG8_MMA(0, 0, At, B0); PG8_BAR; PG8_SCHED;
            PG8_LDB(B1, 1, 1); PG8_STAGE(PG8_SB(1, 0), b3, voffB);
            PG8_BAR; PG8_WAIT_L(0); PG8_MMA(0, 1, At, B1); PG8_BAR;
            PG8_LDA(At, 1, 1); PG8_STAGE(PG8_SA(1, 0), a3, voffA);
            PG8_BAR; PG8_WAIT_L(0); PG8_MMA(1, 0, At, B0); PG8_BAR; PG8_SCHED;
            PG8_STAGE(PG8_SB(1, 1), b3 + hsB, voffB);
            PG8_WAIT_V(6); PG8_BAR; PG8_MMA(1, 1, At, B1); PG8_BAR;
            }
        }
        if constexpr (ALIGN_EPI) { if (wr == 0) PG8_BAR; }
        if constexpr (!Epi::AFTER_DRAIN) { E(acc, cur, wr, wc, fr, fq, pre); S.done(cur); }
        if (!has_next) break;
#pragma unroll
        for (int a = 0; a < 2; ++a)
#pragma unroll
            for (int b = 0; b < 2; ++b)
#pragma unroll
                for (int m = 0; m < 4; ++m)
#pragma unroll
                    for (int n = 0; n < 2; ++n) acc[a][b][m][n] = (f32x4){0.f, 0.f, 0.f, 0.f};
        cur = nxt; cA = nA; cB = nB; ++ui;
        if constexpr (ALIGN_EPI) { if (wr == 1) PG8_BAR; }
    }
    PG8_WAIT_V(0);
    if constexpr (!ALIGN_EPI) { if (wr == 0) PG8_BAR; }
    PG8_BAR;
    if constexpr (Epi::AFTER_DRAIN) { E.fused(acc, cur, wr, wc, fr, fq, lds, wid, lane); S.done(cur); }
#undef PG8_SA
#undef PG8_SB
#undef PG8_STAGE
#undef PG8_LDA
#undef PG8_LDB
#undef PG8_MMA
#undef PG8_WAIT_V
#undef PG8_WAIT_L
#undef PG8_BAR
#undef PG8_SCHED
}
}

using pg8::bf16_t; using pg8::f32x4; using pg8::u32x4; using pg8::bf16x8; using pg8::cvt_pk_bf16;
#define LAS __attribute__((address_space(3)))
typedef _Float16 f16x8 __attribute__((ext_vector_type(8)));
typedef _Float16 f16x4 __attribute__((ext_vector_type(4)));
typedef _Float16 f16x2 __attribute__((ext_vector_type(2)));
typedef short s16x4 __attribute__((ext_vector_type(4)));
typedef unsigned u32x2 __attribute__((ext_vector_type(2)));
typedef float f32x2 __attribute__((ext_vector_type(2)));
typedef unsigned short u16;

constexpr int D = 1024, MTOK = 49152, NB = 10, NLAYER = 4, ZW = 2304, NIN = 3072, DIN = 2816, NPT = 16384;
constexpr float RMS_EPS = 1e-6f, LN_EPS = 1e-5f;
constexpr int NTHR = 512;
constexpr int LDS_BYTES = 158720;
constexpr int NPHASE = 2 + 4 * NLAYER + 1;

constexpr size_t MiB = 1u << 20;
constexpr size_t WS_WIN = 1 * MiB;
constexpr size_t WS_WOUT = 25 * MiB;
constexpr size_t WS_SGUW = 33 * MiB;
constexpr size_t WS_MOD = 34 * MiB;
constexpr size_t WS_SB = 35 * MiB;
constexpr size_t WS_GM = 36 * MiB;
constexpr size_t WS_SSQ = 37 * MiB;
constexpr size_t WS_DFT = 38 * MiB;
constexpr size_t WS_X16 = 40 * MiB;
constexpr size_t WS_Z = 136 * MiB;
constexpr size_t WS_ZT = 352 * MiB;
constexpr size_t WS_W16 = 424 * MiB;
constexpr size_t WS_END = 484 * MiB;
constexpr size_t DF_C128 = 0, DF_S128 = 32768, DF_NS128 = 65536, DF_T1 = 98304, DF_T2 = 99328, DF_TW16K = 102400, DF_TW2K = 233472;

struct Params { const float* in[17]; float* out; unsigned char* ws; int ph_lo, ph_hi; };

__device__ __forceinline__ int batch_of_tile(int pm) { return pm < 64 ? (pm >> 3) : 8 + ((pm - 64) >> 6); }
__device__ __forceinline__ int batch_of_tok(int t) { return t < NPT ? (t >> 11) : 8 + ((t - NPT) >> 14); }
__device__ __forceinline__ float bf2f(unsigned h) { return __uint_as_float(h << 16); }
__device__ __forceinline__ unsigned f2bf(float f) { unsigned u = __float_as_uint(f); return (u + 0x7fffu + ((u >> 16) & 1u)) >> 16; }
__device__ __forceinline__ float sigm(float x) { return __builtin_amdgcn_rcpf(1.f + __expf(-x)); }
__device__ __forceinline__ float silu_(float v) { return v * sigm(v); }
__device__ __forceinline__ float gelu_(float v) { return v * sigm(1.5957691216f * (v + 0.044715f * v * v * v)); }
__device__ __forceinline__ unsigned pkh(float a, float b) { f16x2 h; h.x = (_Float16)a; h.y = (_Float16)b; return __builtin_bit_cast(unsigned, h); }
__device__ __forceinline__ float wave_sum(float v) {
#pragma unroll
    for (int o = 1; o < 64; o <<= 1) v += __shfl_xor(v, o);
    return v;
}
__device__ __forceinline__ void unpack8(const u32x4 v, float (&f)[8]) {
    f[0] = bf2f(v.x & 0xffffu); f[1] = __uint_as_float(v.x & 0xffff0000u); f[2] = bf2f(v.y & 0xffffu); f[3] = __uint_as_float(v.y & 0xffff0000u);
    f[4] = bf2f(v.z & 0xffffu); f[5] = __uint_as_float(v.z & 0xffff0000u); f[6] = bf2f(v.w & 0xffffu); f[7] = __uint_as_float(v.w & 0xffff0000u);
}
__device__ __forceinline__ float quad_max(float x) {
    auto a = __builtin_amdgcn_permlane16_swap(__float_as_uint(x), __float_as_uint(x), false, false); x = fmaxf(__uint_as_float(a[0]), __uint_as_float(a[1]));
    auto b = __builtin_amdgcn_permlane32_swap(__float_as_uint(x), __float_as_uint(x), false, false); return fmaxf(__uint_as_float(b[0]), __uint_as_float(b[1]));
}
__device__ __forceinline__ float quad_sum(float x) {
    auto a = __builtin_amdgcn_permlane16_swap(__float_as_uint(x), __float_as_uint(x), false, false); x = __uint_as_float(a[0]) + __uint_as_float(a[1]);
    auto b = __builtin_amdgcn_permlane32_swap(__float_as_uint(x), __float_as_uint(x), false, false); return __uint_as_float(b[0]) + __uint_as_float(b[1]);
}
typedef short v4i16_t __attribute__((ext_vector_type(4)));
__device__ __forceinline__ bf16x8 tr_frag(LAS const unsigned char* base, int pitch, int row0, int col0, int lane) {
    const int i16 = lane & 15;
    LAS const unsigned char* p = base + (row0 + (i16 >> 2)) * pitch + (col0 + 4 * (i16 & 3)) * 2;
    const v4i16_t lo = __builtin_amdgcn_ds_read_tr16_b64_v4i16((LAS v4i16_t*)p);
    const v4i16_t hi = __builtin_amdgcn_ds_read_tr16_b64_v4i16((LAS v4i16_t*)(p + 4 * pitch));
    bf16x8 r; r[0] = lo[0]; r[1] = lo[1]; r[2] = lo[2]; r[3] = lo[3]; r[4] = hi[0]; r[5] = hi[1]; r[6] = hi[2]; r[7] = hi[3]; return r;
}
__device__ __forceinline__ f32x4 mma_bf16(bf16x8 a, bf16x8 b, f32x4 c) { return __builtin_amdgcn_mfma_f32_16x16x32_bf16(a, b, c, 0, 0, 0); }
__device__ __forceinline__ f32x4 mma_f16(bf16x8 a, bf16x8 b, f32x4 c) { return __builtin_amdgcn_mfma_f32_16x16x32_f16(__builtin_bit_cast(f16x8, a), __builtin_bit_cast(f16x8, b), c, 0, 0, 0); }

struct Epi1 {
    static constexpr bool PERM = true, AFTER_DRAIN = false;
    bf16_t* Z; u16* ZT; const float* ssq; const float* sb; int noact;
    struct Pre { float v[4]; };
    __device__ __forceinline__ void prefetch(Pre& q, const pg8::Unit& u, int wr, int wc, int fr, int fq) const {
        const int b = batch_of_tile(u.pm);
        if (u.pn < 9) { const int row0 = u.pm * 256 + wr * 64 + fr;
#pragma unroll
            for (int i = 0; i < 4; ++i) q.v[i] = ssq[row0 + i * 16];
        } else { const int chr0 = wr * 64 + fr;
#pragma unroll
            for (int i = 0; i < 4; ++i) q.v[i] = sb[b * NIN + u.pn * 256 + chr0 + i * 16]; }
    }
    __device__ __forceinline__ void operator()(const f32x4 (&acc)[2][2][4][2], const pg8::Unit& u, int wr, int wc, int fr, int fq, const Pre& pq) const {
        if (noact == 2) {
#pragma unroll
            for (int ai = 0; ai < 2; ++ai)
#pragma unroll
                for (int bj = 0; bj < 2; ++bj)
#pragma unroll
                    for (int m = 0; m < 4; ++m)
#pragma unroll
                        for (int n = 0; n < 2; ++n) asm volatile("" :: "v"(acc[ai][bj][m][n]));
            return; }
        const int b = batch_of_tile(u.pm);
        if (u.pn < 9) {
            const int act = noact ? 0 : (0x11819u >> (2 * u.pn)) & 3;
            const int row0 = u.pm * 256 + wr * 64 + fr, colt = u.pn * 256 + wc * 32 + 8 * fq;
            f32x4 bv[2][2];
#pragma unroll
            for (int bj = 0; bj < 2; ++bj)
#pragma unroll
                for (int n = 0; n < 2; ++n) bv[bj][n] = *(const f32x4*)(sb + b * NIN + colt + bj * 128 + 4 * n);
            float sq[2][4];
#pragma unroll
            for (int ai = 0; ai < 2; ++ai)
#pragma unroll
                for (int m = 0; m < 4; ++m) sq[ai][m] = ai == 0 ? pq.v[m] : ssq[row0 + 128 + m * 16];
#pragma unroll
            for (int ai = 0; ai < 2; ++ai)
#pragma unroll
                for (int m = 0; m < 4; ++m) {
                    const int row = row0 + ai * 128 + m * 16;
                    const float rs = __builtin_amdgcn_rsqf(sq[ai][m] * (1.f / 1024.f) + RMS_EPS);
                    bf16_t* rowp = Z + (size_t)row * ZW + colt;
#pragma unroll
                    for (int bj = 0; bj < 2; ++bj) {
                        f32x4 v0 = acc[ai][bj][m][0] * rs + bv[bj][0], v1 = acc[ai][bj][m][1] * rs + bv[bj][1];
                        if (act == 1) {
#pragma unroll
                            for (int e = 0; e < 4; ++e) { v0[e] = silu_(v0[e]); v1[e] = silu_(v1[e]); }
                        } else if (act == 2) {
#pragma unroll
                            for (int e = 0; e < 4; ++e) { v0[e] = gelu_(v0[e]); v1[e] = gelu_(v1[e]); }
                        }
                        u32x4 w; w.x = cvt_pk_bf16(v0[0], v0[1]); w.y = cvt_pk_bf16(v0[2], v0[3]); w.z = cvt_pk_bf16(v1[0], v1[1]); w.w = cvt_pk_bf16(v1[2], v1[3]);
                        *(u32x4*)(rowp + bj * 128) = w;
                    }
                }
        } else {
            const int chr0 = wr * 64 + fr, tok0 = u.pm * 256 + wc * 32 + 8 * fq, zr = (u.pn - 9) * 256;
            const bool f16out = u.pn != 11;
            f32x4 rv[2][2];
#pragma unroll
            for (int bj = 0; bj < 2; ++bj)
#pragma unroll
                for (int n = 0; n < 2; ++n) { const f32x4 s = *(const f32x4*)(ssq + tok0 + bj * 128 + 4 * n);
#pragma unroll
                    for (int e = 0; e < 4; ++e) rv[bj][n][e] = __builtin_amdgcn_rsqf(s[e] * (1.f / 1024.f) + RMS_EPS); }
            float bs8[2][4];
#pragma unroll
            for (int ai = 0; ai < 2; ++ai)
#pragma unroll
                for (int m = 0; m < 4; ++m) bs8[ai][m] = ai == 0 ? pq.v[m] : sb[b * NIN + u.pn * 256 + chr0 + 128 + m * 16];
#pragma unroll
            for (int ai = 0; ai < 2; ++ai)
#pragma unroll
                for (int m = 0; m < 4; ++m) {
                    const int ch = chr0 + ai * 128 + m * 16;
                    const float bias = bs8[ai][m];
                    u16* rowp = ZT + (size_t)(zr + ch) * MTOK + tok0;
#pragma unroll
                    for (int bj = 0; bj < 2; ++bj) {
                        const f32x4 v0 = acc[ai][bj][m][0] * rv[bj][0] + bias, v1 = acc[ai][bj][m][1] * rv[bj][1] + bias;
                        u32x4 w;
                        if (f16out) { w.x = pkh(v0[0], v0[1]); w.y = pkh(v0[2], v0[3]); w.z = pkh(v1[0], v1[1]); w.w = pkh(v1[2], v1[3]); }
                        else { w.x = cvt_pk_bf16(v0[0], v0[1]); w.y = cvt_pk_bf16(v0[2], v0[3]); w.z = cvt_pk_bf16(v1[0], v1[1]); w.w = cvt_pk_bf16(v1[2], v1[3]); }
                        *(u32x4*)(rowp + bj * 128) = w;
                    }
                }
        }
    }
};
struct Epi2 {
    static constexpr bool PERM = true, AFTER_DRAIN = false;
    u16* X16; float* ssq; const float* gate; float gscale;
    struct Pre { u32x4 x0[2]; };
    __device__ __forceinline__ void prefetch(Pre& q, const pg8::Unit& u, int wr, int wc, int fr, int fq) const {
        const u16* xr = X16 + (size_t)(u.pm * 256 + wr * 64 + fr) * D + u.pn * 256 + wc * 32 + 8 * fq; q.x0[0] = *(const u32x4*)xr; q.x0[1] = *(const u32x4*)(xr + 128); }
    __device__ __forceinline__ void operator()(const f32x4 (&acc)[2][2][4][2], const pg8::Unit& u, int wr, int wc, int fr, int fq, const Pre& pq) const {
        const int b = batch_of_tile(u.pm);
        const int row0 = u.pm * 256 + wr * 64 + fr, col0 = u.pn * 256 + wc * 32 + 8 * fq;
        f32x4 gv[2][2];
#pragma unroll
        for (int bj = 0; bj < 2; ++bj)
#pragma unroll
            for (int n = 0; n < 2; ++n) gv[bj][n] = *(const f32x4*)(gate + b * NIN + col0 + bj * 128 + 4 * n) * gscale;
        u32x4 xv[5][2];
#define E2_LOAD(k) do { u16* xr = X16 + (size_t)(row0 + ((k) >> 2) * 128 + ((k) & 3) * 16) * D + col0; xv[(k) % 5][0] = *(const u32x4*)xr; xv[(k) % 5][1] = *(const u32x4*)(xr + 128); } while (0)
        xv[0][0] = pq.x0[0]; xv[0][1] = pq.x0[1]; E2_LOAD(1); E2_LOAD(2); E2_LOAD(3);
#pragma unroll
        for (int k = 0; k < 8; ++k) {
            __builtin_amdgcn_sched_barrier(0);
            if (k + 4 < 8) E2_LOAD(k + 4);
            __builtin_amdgcn_sched_barrier(0);
            const int ai = k >> 2, m = k & 3; const int row = row0 + ai * 128 + m * 16;
            u16* xr = X16 + (size_t)row * D + col0;
            float ss = 0.f;
#pragma unroll
            for (int bj = 0; bj < 2; ++bj) {
                const f16x8 h = __builtin_bit_cast(f16x8, xv[k % 5][bj]);
                f32x4 x0, x1;
#pragma unroll
                for (int e = 0; e < 4; ++e) { x0[e] = (float)h[e]; x1[e] = (float)h[4 + e]; }
                x0 = x0 + gv[bj][0] * acc[ai][bj][m][0]; x1 = x1 + gv[bj][1] * acc[ai][bj][m][1];
                ss += (x0[0] * x0[0] + x0[1] * x0[1]) + (x0[2] * x0[2] + x0[3] * x0[3]) + (x1[0] * x1[0] + x1[1] * x1[1]) + (x1[2] * x1[2] + x1[3] * x1[3]);
                u32x4 w; w.x = pkh(x0[0], x0[1]); w.y = pkh(x0[2], x0[3]); w.z = pkh(x1[0], x1[1]); w.w = pkh(x1[2], x1[3]);
                *(u32x4*)(xr + bj * 128) = w;
            }
            ss += __shfl_xor(ss, 16); ss += __shfl_xor(ss, 32);
            if (fq == 0) atomicAdd(ssq + row, ss);
        }
#undef E2_LOAD
    }
};

__device__ __forceinline__ void transpose_item(const float* src, int pitch, int ncols, int K, bf16_t* dst, LAS float* scr, int item, int lane) {
    const int nblk = ncols / 32, kb = item / nblk, nb = item % nblk, k0 = 64 * kb, n0 = 32 * nb;
    f32x4 ld[8];
#pragma unroll
    for (int i = 0; i < 8; ++i) { const int kk = 8 * i + (lane >> 3); ld[i] = *(const f32x4*)(src + (size_t)(k0 + kk) * pitch + n0 + 4 * (lane & 7)); }
#pragma unroll
    for (int i = 0; i < 8; ++i) { const int kk = 8 * i + (lane >> 3); LAS float* d = scr + kk * 33 + 4 * (lane & 7); d[0] = ld[i][0]; d[1] = ld[i][1]; d[2] = ld[i][2]; d[3] = ld[i][3]; }
    asm volatile("s_waitcnt lgkmcnt(0)" ::: "memory");
    const int c = lane & 7;
#pragma unroll
    for (int j = 0; j < 4; ++j) { const int n = (lane >> 3) + 8 * j; const LAS float* s = scr + (8 * c) * 33 + n;
        u32x4 o; o.x = cvt_pk_bf16(s[0 * 33], s[1 * 33]); o.y = cvt_pk_bf16(s[2 * 33], s[3 * 33]); o.z = cvt_pk_bf16(s[4 * 33], s[5 * 33]); o.w = cvt_pk_bf16(s[6 * 33], s[7 * 33]);
        *(u32x4*)(dst + (size_t)(n0 + n) * K + k0 + 8 * c) = o; }
    asm volatile("s_waitcnt lgkmcnt(0)" ::: "memory");
}

__device__ __forceinline__ void phase_p0a(const Params& p, LAS unsigned char* lds, int bid, int G, int tid, int lane, int wave) {
    asm volatile("" : "+v"(tid), "+v"(lane), "+s"(wave), "+s"(bid), "+s"(G));
    size_t wso = 0; asm volatile("" : "+s"(wso)); unsigned char* ws = p.ws + wso;
    const float* w_in = p.in[7]; const float* w_out = p.in[8];
    bf16_t* WinT = (bf16_t*)(ws + WS_WIN); bf16_t* WoutT = (bf16_t*)(ws + WS_WOUT);
    const int gw = bid * 8 + wave, NGW = G * 8, gtid = bid * NTHR + tid, NT = G * NTHR;
    {
        LAS float* scr = (LAS float*)(lds + wave * 8448);
        for (int it = gw; it < 4608 + 2048; it += NGW) {
            if (it < 4608) {
                const int sub = it & 127, lt = it >> 7, l = lt / 9, ti = lt % 9;
                const int pn = ti < 4 ? ti : (ti < 8 ? ti + 1 : 11);
                const int sc = ti == 0 ? 256 : ti == 1 ? 512 : ti == 2 ? 1536 : ti == 3 ? 1792 : ti == 4 ? 768 : ti == 5 ? 1024 : ti == 6 ? 2048 : ti == 7 ? 2560 : 2304;
                transpose_item(w_in + (size_t)l * D * DIN + sc, DIN, 256, D, WinT + ((size_t)l * NIN + pn * 256) * D, scr, sub, lane);
            } else {
                const int r = it - 4608, l = r >> 9, sub = r & 511;
                transpose_item(w_out + (size_t)l * D * D, D, D, D, WoutT + (size_t)l * D * D, scr, sub, lane);
            }
        }
    }
    __syncthreads();
    {
        const float* pool_w = p.in[9]; const float* pool_scale = p.in[10]; const float* fnet_w = p.in[14];
        LAS float* Mf = (LAS float*)lds; LAS float* Wt = (LAS float*)(lds + 16384); LAS float* cs = (LAS float*)(lds + 33024); LAS u16* Ot = (LAS u16*)(lds + 36864); LAS float* Fw = (LAS float*)(lds + 46080);
        for (int it = bid; it < 768; it += G) {
            const int kb = it & 15, g = (it >> 4) & 3, kind = (it >> 6) % 3, l = it / 192;
            if (tid < 64) { cs[tid] = cospif((float)tid * (1.f / 32.f)); cs[64 + tid] = sinpif((float)tid * (1.f / 32.f)); }
            const float* wsrc = w_in + (size_t)l * D * DIN + (kind == 0 ? 0 : 1280) + g * 64;
#pragma unroll
            for (int i = 0; i < 8; ++i) { const int e = tid + 512 * i, kk = e >> 6, c = e & 63; Wt[kk * 65 + c] = wsrc[(size_t)(kb * 64 + kk) * DIN + c]; }
            if (kind != 0) {
#pragma unroll
                for (int i = 0; i < 8; ++i) { const int e = tid + 512 * i; Fw[e] = fnet_w[(l * 4 + g) * 4096 + e]; } }
            __syncthreads();
#pragma unroll 1
            for (int i = 0; i < 8; ++i) {
                const int e = tid + 512 * i, c = e >> 6, d = e & 63; float v;
                if (kind == 0) v = pool_w[((l * 4 + g) * 64 + c) * 64 + d] * pool_scale[l * 256 + g * 64 + d];
                else { float s = 0.f; const int co = kind == 1 ? 0 : 64;
#pragma unroll 16
                    for (int cp = 0; cp < 64; ++cp) s += cs[co + ((c * cp) & 63)] * Fw[cp * 64 + d];
                    v = s * (kind == 1 ? 0.125f : -0.125f); }
                Mf[c * 64 + d] = v;
            }
            __syncthreads();
#pragma unroll 1
            for (int i = 0; i < 8; ++i) { const int kk = wave + 8 * i; float s = 0.f;
#pragma unroll 16
                for (int c = 0; c < 64; ++c) s += Wt[kk * 65 + c] * Mf[c * 64 + lane];
                Ot[lane * 72 + kk] = (u16)f2bf(s); }
            __syncthreads();
            { const int d = tid >> 3, ch = tid & 7, pn = kind == 0 ? 4 : (kind == 1 ? 9 : 10);
              const u32x4 v = *(const LAS u32x4*)(Ot + d * 72 + ch * 8);
              *(u32x4*)(WinT + ((size_t)l * NIN + pn * 256 + g * 64 + d) * D + kb * 64 + ch * 8) = v; }
            __syncthreads();
        }
    }
    { const f32x4* s4 = (const f32x4*)p.in[12]; u32x2* d2 = (u32x2*)(ws + WS_SGUW);
      for (int e = gtid; e < 65536; e += NT) { const f32x4 v = s4[e]; u32x2 o; o.x = cvt_pk_bf16(v[0], v[1]); o.y = cvt_pk_bf16(v[2], v[3]); d2[e] = o; } }
    {
        const float* cp_ = p.in[2]; const float* cs_ = p.in[3]; const float* w_ada = p.in[5]; const float* b_ada = p.in[6]; float* mod = (float*)(ws + WS_MOD);
        LAS float* sc = (LAS float*)lds; LAS float* red = (LAS float*)(lds + 40960);
        for (int it = bid; it < 192; it += G) {
            const int l = it / 48, jb = it % 48;
            for (int e = tid; e < 10240; e += NTHR) { const int b = e >> 10, k = e & 1023; const float cv = b < 8 ? cp_[b * 1024 + k] : cs_[(b - 8) * 1024 + k]; sc[e] = cv / (1.f + expf(-cv)); }
            __syncthreads();
            float a[10];
#pragma unroll
            for (int b = 0; b < 10; ++b) a[b] = 0.f;
            const float* wp = w_ada + ((size_t)l * 1024 + wave * 128) * 3072 + jb * 64 + lane;
#pragma unroll 16
            for (int kk = 0; kk < 128; ++kk) { const float wv = wp[(size_t)kk * 3072];
#pragma unroll
                for (int b = 0; b < 10; ++b) a[b] += sc[b * 1024 + wave * 128 + kk] * wv; }
#pragma unroll
            for (int b = 0; b < 10; ++b) red[(wave * 10 + b) * 64 + lane] = a[b];
            __syncthreads();
            for (int e = tid; e < 640; e += NTHR) { const int b = e >> 6, j = e & 63; float s = 0.f;
#pragma unroll
                for (int w = 0; w < 8; ++w) s += red[(w * 10 + b) * 64 + j];
                mod[(l * 10 + b) * 3072 + jb * 64 + j] = s + b_ada[l * 3072 + jb * 64 + j]; }
            __syncthreads();
        }
    }
    {
        _Float16* C128 = (_Float16*)(ws + WS_DFT + DF_C128); _Float16* S128 = (_Float16*)(ws + WS_DFT + DF_S128); _Float16* NS128 = (_Float16*)(ws + WS_DFT + DF_NS128);
        _Float16* T1 = (_Float16*)(ws + WS_DFT + DF_T1); _Float16* T2 = (_Float16*)(ws + WS_DFT + DF_T2);
        float* TW16K = (float*)(ws + WS_DFT + DF_TW16K); float* TW2K = (float*)(ws + WS_DFT + DF_TW2K);
        for (int e = gtid; e < 16384; e += NT) {
            const int k = e >> 7, n = e & 127, m = (k * n) & 127;
            const float c = cospif((float)m * (1.f / 64.f)) * 0.08838834764831845f, s = sinpif((float)m * (1.f / 64.f)) * 0.08838834764831845f;
            C128[e] = (_Float16)c; S128[e] = (_Float16)s; NS128[e] = (_Float16)(-s);
            const float ang = (float)(k * n) * (1.f / 8192.f);
            TW16K[2 * e] = cospif(ang); TW16K[2 * e + 1] = -sinpif(ang);
        }
        for (int e = gtid; e < 512; e += NT) {
            const int k1 = e >> 5, kk = e & 31, n1 = kk & 15, m = (k1 * n1) & 15;
            const float c = cospif((float)m * 0.125f) * 0.25f, s = sinpif((float)m * 0.125f) * 0.25f;
            T1[e] = (_Float16)(kk < 16 ? c : s); T2[e] = (_Float16)(kk < 16 ? -s : c);
        }
        for (int e = gtid; e < 2048; e += NT) {
            const int k1 = e >> 7, n2 = e & 127; const float ang = (float)(k1 * n2) * (1.f / 1024.f);
            TW2K[2 * e] = cospif(ang); TW2K[2 * e + 1] = -sinpif(ang);
        }
    }
}

__device__ __forceinline__ void gen_w16(const Params& p, unsigned char* ws, int l, int gtid, int NT) {
    const bf16_t* Wm = (const bf16_t*)(ws + WS_WIN) + (size_t)l * NIN * D; u16* W16 = (u16*)(ws + WS_W16);
    const float* sc = (const float*)(ws + WS_MOD) + (size_t)l * NB * 3072 + 1024; const float* ng = p.in[4] + l * D;
    for (int idx = gtid; idx < NIN * 128; idx += NT) {
        const int n = idx >> 7, k8 = (idx & 127) * 8;
        const u32x4 wraw = *(const u32x4*)(Wm + (size_t)n * D + k8);
        const f32x4 g0 = *(const f32x4*)(ng + k8), g1 = *(const f32x4*)(ng + k8 + 4);
        f32x4 s0[NB], s1[NB];
#pragma unroll
        for (int b = 0; b < NB; ++b) { s0[b] = *(const f32x4*)(sc + b * 3072 + k8); s1[b] = *(const f32x4*)(sc + b * 3072 + k8 + 4); }
        __builtin_amdgcn_sched_barrier(0);
        float w[8]; unpack8(wraw, w);
#pragma unroll
        for (int b = 0; b < NB; ++b) {
            const f32x4 m0 = g0 * (1.f + s0[b]), m1 = g1 * (1.f + s1[b]);
            u32x4 o; o.x = pkh(w[0] * m0[0], w[1] * m0[1]); o.y = pkh(w[2] * m0[2], w[3] * m0[3]); o.z = pkh(w[4] * m1[0], w[5] * m1[1]); o.w = pkh(w[6] * m1[2], w[7] * m1[3]);
            *(u32x4*)(W16 + ((size_t)b * NIN + n) * D + k8) = o;
        }
    }
}

__device__ __forceinline__ void phase_p0b(const Params& p, LAS unsigned char* lds, int bid, int G, int tid, int lane, int wave) {
    asm volatile("" : "+v"(tid), "+v"(lane), "+s"(wave), "+s"(bid), "+s"(G));
    size_t wso = 0; asm volatile("" : "+s"(wso)); unsigned char* ws = p.ws + wso;
    const float* mod = (const float*)(ws + WS_MOD); const float* norm_g = p.in[4];
    const int gw = bid * 8 + wave, NGW = G * 8, gtid = bid * NTHR + tid, NT = G * NTHR;
    {
        const bf16_t* WinT = (const bf16_t*)(ws + WS_WIN); float* sb = (float*)(ws + WS_SB);
        const int fr = lane & 15, quad = lane >> 4;
        for (int it = gw; it < NLAYER * (NIN / 16); it += NGW) {
            const int l = it / (NIN / 16), n0 = (it % (NIN / 16)) * 16;
            const bf16_t* wrow = WinT + ((size_t)l * NIN + n0 + fr) * D + quad * 8;
            const float* srow = mod + (size_t)(l * NB + (fr < NB ? fr : 0)) * 3072 + quad * 8;
            f32x4 acc0 = (f32x4){0.f, 0.f, 0.f, 0.f}, acc1 = acc0;
#pragma unroll 1
            for (int kh = 0; kh < 2; ++kh) {
                bf16x8 bw[16]; f32x4 sa[16][2];
#pragma unroll
                for (int ks = 0; ks < 16; ++ks) { const int k0 = (kh * 16 + ks) * 32; bw[ks] = *(const bf16x8*)(wrow + k0); sa[ks][0] = *(const f32x4*)(srow + k0); sa[ks][1] = *(const f32x4*)(srow + k0 + 4); }
                __builtin_amdgcn_sched_barrier(0);
#pragma unroll
                for (int ks = 0; ks < 16; ++ks) {
                    u32x4 aw; aw.x = cvt_pk_bf16(sa[ks][0][0], sa[ks][0][1]); aw.y = cvt_pk_bf16(sa[ks][0][2], sa[ks][0][3]); aw.z = cvt_pk_bf16(sa[ks][1][0], sa[ks][1][1]); aw.w = cvt_pk_bf16(sa[ks][1][2], sa[ks][1][3]);
                    if (fr >= NB) aw = (u32x4){0u, 0u, 0u, 0u};
                    if (ks & 1) acc1 = mma_bf16(__builtin_bit_cast(bf16x8, aw), bw[ks], acc1); else acc0 = mma_bf16(__builtin_bit_cast(bf16x8, aw), bw[ks], acc0);
                }
            }
#pragma unroll
            for (int j = 0; j < 4; ++j) { const int b = quad * 4 + j; if (b < NB) sb[(size_t)(l * NB + b) * NIN + n0 + fr] = acc0[j] + acc1[j]; }
        }
    }
    {
        u16* X16 = (u16*)(ws + WS_X16); float* ssq = (float*)(ws + WS_SSQ);
        for (int row0 = gw * 8; row0 < MTOK; row0 += NGW * 8) {
            const float* xr = row0 < NPT ? p.in[0] + (size_t)row0 * D : p.in[1] + (size_t)(row0 - NPT) * D;
            f32x4 v[8][4];
#pragma unroll
            for (int r = 0; r < 8; ++r)
#pragma unroll
                for (int j = 0; j < 4; ++j) v[r][j] = *(const f32x4*)(xr + (size_t)r * D + 4 * (lane + 64 * j));
            __builtin_amdgcn_sched_barrier(0);
#pragma unroll
            for (int r = 0; r < 8; ++r) {
                float ss = 0.f;
#pragma unroll
                for (int j = 0; j < 4; ++j) {
                    const f32x4 x = v[r][j];
                    ss += (x[0] * x[0] + x[1] * x[1]) + (x[2] * x[2] + x[3] * x[3]);
                    u32x2 o; o.x = pkh(x[0], x[1]); o.y = pkh(x[2], x[3]);
                    *(u32x2*)(X16 + (size_t)(row0 + r) * D + 4 * (lane + 64 * j)) = o;
                }
                ss = wave_sum(ss);
                if (lane == 0) ssq[row0 + r] = ss;
            }
        }
    }
    gen_w16(p, ws, 0, gtid, NT);
}

__device__ __forceinline__ void phase_final(const Params& p, int bid, int G, int lane, int wave) {
    const float* ssq = (const float*)(p.ws + WS_SSQ); const float* fg = p.in[16]; const u16* X16 = (const u16*)(p.ws + WS_X16);
    const int gw = bid * 8 + wave, NGW = G * 8;
    for (int row0 = gw * 8; row0 < MTOK; row0 += NGW * 8) {
        u32x4 xh[8][2]; float sq[8];
#pragma unroll
        for (int r = 0; r < 8; ++r) { sq[r] = ssq[row0 + r]; xh[r][0] = *(const u32x4*)(X16 + (size_t)(row0 + r) * D + lane * 8); xh[r][1] = *(const u32x4*)(X16 + (size_t)(row0 + r) * D + 512 + lane * 8); }
        f32x4 g[2][2];
#pragma unroll
        for (int hh = 0; hh < 2; ++hh) { g[hh][0] = *(const f32x4*)(fg + hh * 512 + lane * 8); g[hh][1] = *(const f32x4*)(fg + hh * 512 + lane * 8 + 4); }
        __builtin_amdgcn_sched_barrier(0);
#pragma unroll
        for (int r = 0; r < 8; ++r) { const float rs = __builtin_amdgcn_rsqf(sq[r] * (1.f / 1024.f) + RMS_EPS);
            float* orow = p.out + (size_t)(row0 + r) * D + lane * 8;
#pragma unroll
            for (int hh = 0; hh < 2; ++hh) { const f16x8 h = __builtin_bit_cast(f16x8, xh[r][hh]);
                f32x4 a, c;
#pragma unroll
                for (int e = 0; e < 4; ++e) { a[e] = (float)h[e] * rs; c[e] = (float)h[4 + e] * rs; }
                *(f32x4*)(orow + hh * 512) = a * g[hh][0]; *(f32x4*)(orow + hh * 512 + 4) = c * g[hh][1]; } }
    }
}

constexpr int FP = 272;
constexpr int F_UP = 0, F_UQ = 34816, F_APR = 69632, F_API = 104448, F_YST = 0;

__device__ __forceinline__ void phase_p2a(const Params& p, LAS unsigned char* lds, int bid, int G, int tid, int lane, int wave, const int mode = 3) {
    asm volatile("" : "+v"(tid), "+v"(lane), "+s"(wave), "+s"(bid), "+s"(G));
    size_t wso = 0; asm volatile("" : "+s"(wso)); unsigned char* ws = p.ws + wso;
    const int gtid = bid * NTHR + tid, NT = G * NTHR, fr = lane & 15, quad = lane >> 4;
    { float* ssq = (float*)(ws + WS_SSQ); for (int e = gtid; e < MTOK; e += NT) ssq[e] = 0.f; }
    const u16* ZT = (const u16*)(ws + WS_ZT); u16* YT = (u16*)(ws + WS_ZT);
    const bf16x8* C128 = (const bf16x8*)(ws + WS_DFT + DF_C128); const bf16x8* S128 = (const bf16x8*)(ws + WS_DFT + DF_S128); const bf16x8* NS128 = (const bf16x8*)(ws + WS_DFT + DF_NS128);
    const bf16x8* T1 = (const bf16x8*)(ws + WS_DFT + DF_T1); const bf16x8* T2 = (const bf16x8*)(ws + WS_DFT + DF_T2);
    const f32x2* TW16K = (const f32x2*)(ws + WS_DFT + DF_TW16K); const f32x2* TW2K = (const f32x2*)(ws + WS_DFT + DF_TW2K);
    u32x4 stU[8];
#define FFT_ISSUE(uu) do { const bool big_ = (uu) < 512; int bs_, ch0_; \
        if (big_) { bs_ = NPT + ((uu) >> 8) * 16384; ch0_ = (uu) & 255; } else { const int v_ = (uu) - 512; bs_ = (v_ >> 5) * 2048; ch0_ = (v_ & 31) * 8; } \
        _Pragma("unroll") for (int i = 0; i < 8; ++i) { const int c = tid + 512 * i, mat = c >> 11, cc = c & 2047, r = cc >> 4, k16 = cc & 15; \
            const int chan = big_ ? ch0_ : ch0_ + (r >> 4), roff = big_ ? r * 128 : (r & 15) * 128; \
            stU[i] = *(const u32x4*)(ZT + (size_t)(mat * 256 + chan) * MTOK + bs_ + roff + k16 * 8); } } while (0)
    if ((mode & 1) && bid < 768) FFT_ISSUE(bid);
    bf16x8 cf[4], sf[4], nsf[4];
#pragma unroll
    for (int ks = 0; ks < 4; ++ks) { const int off = ((wave * 16 + fr) * 128 + ks * 32 + quad * 8) >> 3; cf[ks] = C128[off]; sf[ks] = S128[off]; nsf[ks] = NS128[off]; }
    if (mode & 1)
    for (int u = bid; u < 768; u += G) {
        const bool big = u < 512;
        int bs, ch0;
        if (big) { bs = NPT + (u >> 8) * 16384; ch0 = u & 255; } else { const int v = u - 512; bs = (v >> 5) * 2048; ch0 = (v & 31) * 8; }
#pragma unroll
        for (int i = 0; i < 8; ++i) { const int c = tid + 512 * i, mat = c >> 11, cc = c & 2047, r = cc >> 4, k16 = cc & 15; *(LAS u32x4*)(lds + mat * 34816 + r * FP + k16 * 16) = stU[i]; }
        f32x2 twn[4];
#pragma unroll
        for (int j = 0; j < 4; ++j) twn[j] = big ? TW16K[(wave * 16 + quad * 4 + j) * 128 + fr] : TW2K[(quad * 4 + j) * 128 + fr];
        __syncthreads();
        { const int un = (u + G < 768) ? u + G : u; FFT_ISSUE(un); }
        __builtin_amdgcn_sched_barrier(0);
        if (big) {
            const int mt = wave;
#pragma unroll 2
            for (int nt = 0; nt < 8; ++nt) {
                f32x2 twc[4];
#pragma unroll
                for (int j = 0; j < 4; ++j) { twc[j] = twn[j]; twn[j] = TW16K[(mt * 16 + quad * 4 + j) * 128 + min(nt + 1, 7) * 16 + fr]; }
                bf16x8 bu[4], bi[4];
#pragma unroll
                for (int ks = 0; ks < 4; ++ks) { bu[ks] = tr_frag(lds + F_UP, FP, ks * 32 + quad * 8, nt * 16, lane); bi[ks] = tr_frag(lds + F_UQ, FP, ks * 32 + quad * 8, nt * 16, lane); }
                f32x4 ar = (f32x4){0.f, 0.f, 0.f, 0.f}, ai = (f32x4){0.f, 0.f, 0.f, 0.f};
#pragma unroll
                for (int ks = 0; ks < 4; ++ks) { ar = mma_f16(cf[ks], bu[ks], ar); ar = mma_f16(sf[ks], bi[ks], ar); ai = mma_f16(cf[ks], bi[ks], ai); ai = mma_f16(nsf[ks], bu[ks], ai); }
                const int n2 = nt * 16 + fr;
                f16x4 pr, pi;
#pragma unroll
                for (int j = 0; j < 4; ++j) { const f32x2 t2_ = twc[j];
                    pr[j] = (_Float16)(ar[j] * t2_.x - ai[j] * t2_.y); pi[j] = (_Float16)(ar[j] * t2_.y + ai[j] * t2_.x); }
                *(LAS f16x4*)(lds + F_APR + n2 * FP + (mt * 16 + quad * 4) * 2) = pr;
                *(LAS f16x4*)(lds + F_API + n2 * FP + (mt * 16 + quad * 4) * 2) = pi;
            }
        } else {
            const bf16x8 t1 = T1[(fr * 32 + quad * 8) >> 3], t2 = T2[(fr * 32 + quad * 8) >> 3];
#pragma unroll 2
            for (int nt = 0; nt < 8; ++nt) {
                const bf16x8 bf = tr_frag(lds + (quad < 2 ? F_UP : F_UQ), FP, wave * 16 + (quad & 1) * 8, nt * 16, lane);
                f32x2 twc[4];
#pragma unroll
                for (int j = 0; j < 4; ++j) { twc[j] = twn[j]; twn[j] = TW2K[(quad * 4 + j) * 128 + min(nt + 1, 7) * 16 + fr]; }
                const f32x4 z4 = (f32x4){0.f, 0.f, 0.f, 0.f};
                const f32x4 ar = mma_f16(t1, bf, z4), ai = mma_f16(t2, bf, z4);
                const int n2 = nt * 16 + fr;
                f16x4 pr, pi;
#pragma unroll
                for (int j = 0; j < 4; ++j) { const f32x2 tw = twc[j];
                    pr[j] = (_Float16)(ar[j] * tw.x - ai[j] * tw.y); pi[j] = (_Float16)(ar[j] * tw.y + ai[j] * tw.x); }
                *(LAS f16x4*)(lds + F_APR + n2 * FP + (wave * 16 + quad * 4) * 2) = pr;
                *(LAS f16x4*)(lds + F_API + n2 * FP + (wave * 16 + quad * 4) * 2) = pi;
            }
        }
        __syncthreads();
        {
            const int mt = wave;
#pragma unroll 2
            for (int nt = 0; nt < 8; ++nt) {
                bf16x8 br[4], bq[4];
#pragma unroll
                for (int ks = 0; ks < 4; ++ks) { br[ks] = tr_frag(lds + F_APR, FP, ks * 32 + quad * 8, nt * 16, lane); bq[ks] = tr_frag(lds + F_API, FP, ks * 32 + quad * 8, nt * 16, lane); }
                f32x4 y = (f32x4){0.f, 0.f, 0.f, 0.f};
#pragma unroll
                for (int ks = 0; ks < 4; ++ks) { y = mma_f16(cf[ks], br[ks], y); y = mma_f16(sf[ks], bq[ks], y); }
                const int col = nt * 16 + fr;
#pragma unroll
                for (int j = 0; j < 4; ++j) { const int k2 = mt * 16 + quad * 4 + j; *(LAS _Float16*)(lds + F_YST + (k2 * 128 + col) * 2) = (_Float16)y[j]; }
            }
        }
        __syncthreads();
#pragma unroll
        for (int i = 0; i < 4; ++i) {
            const int c = tid + 512 * i;
            if (big) { const u32x4 v = *(const LAS u32x4*)(lds + F_YST + c * 16); *(u32x4*)(YT + (size_t)ch0 * MTOK + bs + c * 8) = v; }
            else { const int chl = c >> 8, k2 = (c & 255) >> 1, h8 = c & 1;
                const u32x4 v = *(const LAS u32x4*)(lds + F_YST + (k2 * 128 + chl * 16 + h8 * 8) * 2);
                *(u32x4*)(YT + (size_t)(ch0 + chl) * MTOK + bs + k2 * 16 + h8 * 8) = v; }
        }
        __syncthreads();
    }
    if (mode & 2) {
        bf16_t* Z = (bf16_t*)(ws + WS_Z);
        for (int idx = gtid; idx < (MTOK / 4) * 32; idx += NT) {
            const int t0 = (idx >> 5) * 4, cg8 = idx & 31, g = cg8 >> 3, half = 1 << g;
            const int b = batch_of_tok(t0), bs = b < 8 ? b * 2048 : NPT + (b - 8) * 16384, be = bs + (b < 8 ? 2048 : 16384);
            const bf16_t* ap = Z + 1024 + cg8 * 8;
            u32x4 rw[19], gt4[4];
#pragma unroll
            for (int i = 0; i < 19; ++i) { const int off = i - 8, tt = t0 + off; rw[i] = (u32x4){0u, 0u, 0u, 0u}; if (off >= -half && off < 3 + half && tt >= bs && tt < be) rw[i] = *(const u32x4*)(ap + (size_t)tt * ZW); }
#pragma unroll
            for (int k = 0; k < 4; ++k) gt4[k] = *(const u32x4*)(Z + (size_t)(t0 + k) * ZW + cg8 * 8);
            __builtin_amdgcn_sched_barrier(0);
            float s[4][8];
#pragma unroll
            for (int k = 0; k < 4; ++k)
#pragma unroll
                for (int e = 0; e < 8; ++e) s[k][e] = 0.f;
#pragma unroll
            for (int i = 0; i < 19; ++i) { float f[8]; unpack8(rw[i], f); const int off = i - 8;
#pragma unroll
                for (int k = 0; k < 4; ++k) { const bool in = (off >= k - half) && (off < k + half);
#pragma unroll
                    for (int e = 0; e < 8; ++e) s[k][e] += in ? f[e] : 0.f; } }
#pragma unroll
            for (int k = 0; k < 4; ++k) {
                const int t = t0 + k, lo = max(t - half, bs), hi = min(t + half, be);
                const float inv = 1.f / (float)(hi - lo);
                float a[8], gt[8]; unpack8(rw[8 + k], a); unpack8(gt4[k], gt);
                float o[8];
#pragma unroll
                for (int e = 0; e < 8; ++e) o[e] = (s[k][e] * inv - a[e]) * gt[e];
                u32x4 w; w.x = cvt_pk_bf16(o[0], o[1]); w.y = cvt_pk_bf16(o[2], o[3]); w.z = cvt_pk_bf16(o[4], o[5]); w.w = cvt_pk_bf16(o[6], o[7]);
                bf16_t* op = (mode & 4) ? (bf16_t*)(ws + WS_END) + (size_t)t * 256 + cg8 * 8 : Z + (size_t)t * ZW + cg8 * 8;
                *(u32x4*)op = w;
            }
        }
    }
}

constexpr int VP = 528;
constexpr int SGS_OFF = 69632;
constexpr int NAK_OFF = 0, NAKP = 144, NAV_OFF = 73728, NAVP = 1040;
constexpr int RPB_OFF = 140288;
constexpr int NAEX_OFF = 147728;

__device__ __forceinline__ void phase_p2b(const Params& p, LAS unsigned char* lds, int l, int bid, int G, int tid, int lane, int wave, const int mode = 7) {
    asm volatile("" : "+v"(tid), "+v"(lane), "+s"(wave), "+s"(bid), "+s"(G));
    size_t wso = 0; asm volatile("" : "+s"(wso)); unsigned char* ws = p.ws + wso;
    bf16_t* Z = (bf16_t*)(ws + WS_Z);
    const int fr = lane & 15, quad = lane >> 4;
    { LAS float* rp = (LAS float*)(lds + RPB_OFF); const float* src = p.in[15] + l * 1860; for (int e = tid; e < 1860; e += NTHR) rp[e] = src[e] * 1.44269504089f; }
    __syncthreads();
    bf16_t* DUM = (bf16_t*)(ws + WS_END);
    if (mode & 1) {
        const float* ng = p.in[11] + l * 256; const float* sgb = p.in[13] + l * 512; const bf16_t* SW = (const bf16_t*)(ws + WS_SGUW) + (size_t)l * 4 * 128 * 128;
        const int vcu_s = (G % 8 == 0) ? (bid % 8) * (G / 8) + bid / 8 : bid;
        for (int it = vcu_s; it < 384; it += G) {
            const int t0 = it * 128;
            {
                const int slot = tid >> 5, ck = tid & 31;
                u32x4 vraw[8];
#pragma unroll
                for (int i = 0; i < 8; ++i) vraw[i] = *(const u32x4*)(Z + (size_t)(t0 + i * 16 + slot) * ZW + 1280 + ck * 8);
                const f32x4 g0 = *(const f32x4*)(ng + ck * 8), g1 = *(const f32x4*)(ng + ck * 8 + 4);
                __builtin_amdgcn_sched_barrier(0);
#pragma unroll
                for (int i = 0; i < 8; ++i) {
                    float v[8]; unpack8(vraw[i], v);
                    float s1 = 0.f, s2 = 0.f;
#pragma unroll
                    for (int e = 0; e < 8; ++e) { s1 += v[e]; s2 += v[e] * v[e]; }
#pragma unroll
                    for (int o = 1; o < 32; o <<= 1) { s1 += __shfl_xor(s1, o); s2 += __shfl_xor(s2, o); }
                    const float mean = s1 * (1.f / 256.f), rstd = __builtin_amdgcn_rsqf(fmaxf(s2 * (1.f / 256.f) - mean * mean, 0.f) + LN_EPS);
                    u32x4 w; w.x = cvt_pk_bf16((v[0] - mean) * rstd * g0[0], (v[1] - mean) * rstd * g0[1]); w.y = cvt_pk_bf16((v[2] - mean) * rstd * g0[2], (v[3] - mean) * rstd * g0[3]);
                    w.z = cvt_pk_bf16((v[4] - mean) * rstd * g1[0], (v[5] - mean) * rstd * g1[1]); w.w = cvt_pk_bf16((v[6] - mean) * rstd * g1[2], (v[7] - mean) * rstd * g1[3]);
                    *(LAS u32x4*)(lds + (i * 16 + slot) * VP + ck * 16) = w;
                }
            }
            u32x4 uu[8];
            { const int slot = tid >> 5, ck = tid & 31;
#pragma unroll
              for (int i = 0; i < 8; ++i) uu[i] = *(const u32x4*)(Z + (size_t)(t0 + i * 16 + slot) * ZW + 256 + ck * 8); }
            {
                const int h = wave >> 1, ph = wave & 1;
                bf16x8 bw[4][4]; float bias[4];
#pragma unroll
                for (int nt = 0; nt < 4; ++nt) {
                    const int prow = ph * 64 + nt * 16 + fr;
#pragma unroll
                    for (int ks = 0; ks < 4; ++ks) bw[nt][ks] = *(const bf16x8*)(SW + ((size_t)h * 128 + prow) * 128 + ks * 32 + quad * 8);
                    bias[nt] = sgb[h * 128 + prow];
                }
                __builtin_amdgcn_sched_barrier(0);
                __syncthreads();
                bf16x8 a[4][4];
#pragma unroll
                for (int mt = 0; mt < 4; ++mt)
#pragma unroll
                    for (int ks = 0; ks < 4; ++ks) a[mt][ks] = tr_frag(lds, VP, ks * 32 + quad * 8, h * 64 + mt * 16, lane);
#pragma unroll
                for (int nt = 0; nt < 4; ++nt) {
                    f32x4 acc[4];
#pragma unroll
                    for (int mt = 0; mt < 4; ++mt) acc[mt] = (f32x4){0.f, 0.f, 0.f, 0.f};
                    const int prow = ph * 64 + nt * 16 + fr;
#pragma unroll
                    for (int ks = 0; ks < 4; ++ks)
#pragma unroll
                        for (int mt = 0; mt < 4; ++mt) acc[mt] = mma_bf16(a[mt][ks], bw[nt][ks], acc[mt]);
#pragma unroll
                    for (int mt = 0; mt < 4; ++mt) {
                        const int c = h * 64 + mt * 16 + quad * 4; const float bb = bias[nt];
                        u32x2 w; w.x = pkh(acc[mt][0] + bb, acc[mt][1] + bb); w.y = pkh(acc[mt][2] + bb, acc[mt][3] + bb);
                        *(LAS u32x2*)(lds + SGS_OFF + prow * VP + c * 2) = w;
                    }
                }
            }
            __syncthreads();
            {
                const int slot = tid >> 5, ck = tid & 31;
                u32x4 gg[8];
#pragma unroll
                for (int i = 0; i < 8; ++i) gg[i] = *(const u32x4*)(Z + (size_t)(t0 + i * 16 + slot) * ZW + 1536 + ck * 8);
                __builtin_amdgcn_sched_barrier(0);
#pragma unroll
                for (int i = 0; i < 8; ++i) {
                    const int prow = i * 16 + slot;
                    const f16x8 sv = __builtin_bit_cast(f16x8, *(const LAS u32x4*)(lds + SGS_OFF + prow * VP + ck * 16));
                    float uf[8], gf[8]; unpack8(uu[i], uf); unpack8(gg[i], gf);
                    u32x4 w; w.x = cvt_pk_bf16(uf[0] * (float)sv[0] * gf[0], uf[1] * (float)sv[1] * gf[1]); w.y = cvt_pk_bf16(uf[2] * (float)sv[2] * gf[2], uf[3] * (float)sv[3] * gf[3]);
                    w.z = cvt_pk_bf16(uf[4] * (float)sv[4] * gf[4], uf[5] * (float)sv[5] * gf[5]); w.w = cvt_pk_bf16(uf[6] * (float)sv[6] * gf[6], uf[7] * (float)sv[7] * gf[7]);
                    if (mode & 8) *(u32x4*)(DUM + (size_t)(t0 + prow) * 256 + ck * 8) = w; else *(u32x4*)(Z + (size_t)(t0 + prow) * ZW + 256 + ck * 8) = w;
                }
            }
            __syncthreads();
        }
    }
    if (mode & 2) {
        const u16* ZT = (const u16*)(ws + WS_ZT);
        const LAS float* rpb = (const LAS float*)(lds + RPB_OFF);
        const int vcu = (G % 8 == 0) ? (bid % 8) * (G / 8) + bid / 8 : bid;
        int jbeg, jend;
        if (G == 256) { jbeg = vcu * 12; jend = jbeg + 12; }
        else { const int per = (3072 + G - 1) / G; jbeg = min(3072, vcu * per); jend = min(3072, jbeg + per); }
        const int cb = wave & 3, half = wave >> 2, c0 = cb == 0 ? 0 : (cb == 1 ? 8 : (cb == 2 ? 24 : 32)), qc = cb * 16 + fr, cst = min(max(qc - 8, 0), 48);
        u32x4 stK0 = (u32x4){0u, 0u, 0u, 0u}, stV0 = stK0; bf16x8 qn[2]; u32x2 ggn[4] = {(u32x2){0u, 0u}, (u32x2){0u, 0u}, (u32x2){0u, 0u}, (u32x2){0u, 0u}};
#define NA_DECODE(j, h_, r_, bs_, rs_) const int h_ = ((j) / 12) & 3; int r_, bs_, rs_; { const int R_ = ((j) / 48) * 12 + (j) % 12; int rows_; \
        if (R_ < 256) { r_ = R_ & 31; rows_ = 32; bs_ = (R_ >> 5) * 2048; } else { const int R2_ = R_ - 256; r_ = R2_ & 255; rows_ = 256; bs_ = NPT + (R2_ >> 8) * 16384; } \
        rs_ = min(max(r_ - 4, 0), rows_ - 8); }
        int pbs = -1, prs = 0, ph = -1, nkind = 2;
        float bvs[4][8]; int pbk = -1;
#pragma unroll
        for (int a_ = 0; a_ < 4; ++a_)
#pragma unroll
            for (int b_ = 0; b_ < 8; ++b_) bvs[a_][b_] = 0.f;
#define NA_KIND(h_, bs_, rs_) (((bs_) == pbs && (h_) == ph) ? ((rs_) == prs ? 0 : ((rs_) == prs + 1 ? 1 : 2)) : 2)
#define NA_ISSUE(kind_, h_, r_, bs_, rs_) do { \
        if ((kind_) == 1) { const int tb_ = bs_ + (rs_ + 7) * 64; \
            stK0 = *(const u32x4*)(Z + (size_t)(tb_ + (tid >> 3)) * ZW + 1792 + h_ * 64 + (tid & 7) * 8); \
            stV0 = *(const u32x4*)(ZT + (size_t)(512 + h_ * 64 + (tid >> 3)) * MTOK + tb_ + (tid & 7) * 8); } \
        const bf16_t* zq_ = Z + (size_t)(bs_ + r_ * 64 + qc) * ZW; \
        _Pragma("unroll") for (int ks = 0; ks < 2; ++ks) qn[ks] = *(const bf16x8*)(zq_ + 768 + h_ * 64 + ks * 32 + quad * 8); \
        if (half == 0) { _Pragma("unroll") for (int mt = 0; mt < 4; ++mt) ggn[mt] = *(const u32x2*)(zq_ + 2048 + h_ * 64 + mt * 16 + quad * 4); }     \
        pbs = bs_; prs = rs_; ph = h_; } while (0)
        if (jbeg < jend) { NA_DECODE(jbeg, h0, r0, bs0, rs0); NA_ISSUE(2, h0, r0, bs0, rs0); }
#pragma unroll 1
        for (int j = jbeg; j < jend; ++j) {
            NA_DECODE(j, h, r, bs, rs);
            const int kind = nkind;
            if (kind == 2) {
                const int tb = bs + rs * 64; u32x4 fk[8], fv[8];
#pragma unroll
                for (int i = 0; i < 8; ++i) { const int idx = tid + 512 * i;
                    fk[i] = *(const u32x4*)(Z + (size_t)(tb + (idx >> 3)) * ZW + 1792 + h * 64 + (idx & 7) * 8);
                    fv[i] = *(const u32x4*)(ZT + (size_t)(512 + h * 64 + (idx >> 6)) * MTOK + tb + (idx & 63) * 8); }
#pragma unroll
                for (int i = 0; i < 8; ++i) { const int idx = tid + 512 * i;
                    *(LAS u32x4*)(lds + NAK_OFF + ((((rs + (idx >> 9)) & 7) * 64) + ((idx >> 3) & 63)) * NAKP + (idx & 7) * 16) = fk[i];
                    *(LAS u32x4*)(lds + NAV_OFF + (idx >> 6) * NAVP + ((((rs + ((idx & 63) >> 3)) & 7) * 64) + (idx & 7) * 8) * 2) = fv[i]; }
            } else if (kind == 1) {
                const int sl = (rs + 7) & 7;
                *(LAS u32x4*)(lds + NAK_OFF + (sl * 64 + (tid >> 3)) * NAKP + (tid & 7) * 16) = stK0;
                *(LAS u32x4*)(lds + NAV_OFF + (tid >> 3) * NAVP + (sl * 64 + (tid & 7) * 8) * 2) = stV0;
            }
            bf16x8 qf[2]; u32x2 gg[4];
#pragma unroll
            for (int ks = 0; ks < 2; ++ks) qf[ks] = qn[ks];
#pragma unroll
            for (int mt = 0; mt < 4; ++mt) gg[mt] = ggn[mt];
            __syncthreads();
            { const int jn = min(j + 1, jend - 1); NA_DECODE(jn, hn, rn, bsn, rsn); nkind = NA_KIND(hn, bsn, rsn); NA_ISSUE(nkind, hn, rn, bsn, rsn); }
            __builtin_amdgcn_sched_barrier(0);
            f32x4 s[8];
            {
                bf16x8 kfr[8][2];
#pragma unroll
                for (int w4 = 0; w4 < 4; ++w4)
#pragma unroll
                    for (int hf = 0; hf < 2; ++hf) {
                        const int key = ((rs + half * 4 + w4) & 7) * 64 + c0 + 8 * (fr >> 2) + (fr & 3) + 4 * hf;
                        const LAS unsigned char* ka = lds + NAK_OFF + key * NAKP + quad * 16;
                        kfr[w4 * 2 + hf][0] = *(const LAS bf16x8*)ka; kfr[w4 * 2 + hf][1] = *(const LAS bf16x8*)(ka + 64);
                    }
                __builtin_amdgcn_sched_barrier(0);
#pragma unroll
                for (int nt = 0; nt < 8; ++nt) { const f32x4 t = mma_bf16(kfr[nt][0], qf[0], (f32x4){0.f, 0.f, 0.f, 0.f}); s[nt] = mma_bf16(kfr[nt][1], qf[1], t); }
            }
            { const int bk = h * 64 + (rs - r + 16);
              if (bk != pbk) { pbk = bk;
                const LAS float* rp = rpb + h * 465;
#pragma unroll
                for (int w4 = 0; w4 < 4; ++w4) {
                    const int dr = rs + half * 4 + w4 - r + 7;
#pragma unroll
                    for (int hf = 0; hf < 2; ++hf)
#pragma unroll
                        for (int jj = 0; jj < 4; ++jj) {
                            const int kc = c0 + 8 * quad + 4 * hf + jj;
                            const bool valid = (kc >= cst) && (kc < cst + 16);
                            bvs[w4][hf * 4 + jj] = rp[valid ? dr * 31 + (kc - qc + 15) : 0];
                        }
                    asm volatile("" : "+v"(bvs[w4][0]), "+v"(bvs[w4][1]), "+v"(bvs[w4][2]), "+v"(bvs[w4][3]), "+v"(bvs[w4][4]), "+v"(bvs[w4][5]), "+v"(bvs[w4][6]), "+v"(bvs[w4][7]));
                } } }
            float mx = -INFINITY;
#pragma unroll
            for (int w4 = 0; w4 < 4; ++w4)
#pragma unroll
                for (int hf = 0; hf < 2; ++hf)
#pragma unroll
                    for (int jj = 0; jj < 4; ++jj) {
                        const int kc = c0 + 8 * quad + 4 * hf + jj;
                        const bool valid = (kc >= cst) && (kc < cst + 16);
                        const float v = valid ? s[w4 * 2 + hf][jj] * 0.18033688011f + bvs[w4][hf * 4 + jj] : -INFINITY;
                        s[w4 * 2 + hf][jj] = v; mx = fmaxf(mx, v);
                    }
            mx = quad_max(mx);
            float lsum = 0.f;
#pragma unroll
            for (int nt = 0; nt < 8; ++nt)
#pragma unroll
                for (int jj = 0; jj < 4; ++jj) { const float pe = __builtin_amdgcn_exp2f(s[nt][jj] - mx); s[nt][jj] = pe; lsum += pe; }
            lsum = quad_sum(lsum);
            f32x4 o[4];
#pragma unroll
            for (int mt = 0; mt < 4; ++mt) o[mt] = (f32x4){0.f, 0.f, 0.f, 0.f};
#pragma unroll
            for (int wb = 0; wb < 2; ++wb) {
                bf16x8 vfr[2][4];
#pragma unroll
                for (int wi = 0; wi < 2; ++wi)
#pragma unroll
                    for (int mt = 0; mt < 4; ++mt) vfr[wi][mt] = *(const LAS bf16x8*)(lds + NAV_OFF + (mt * 16 + fr) * NAVP + (((rs + half * 4 + wb * 2 + wi) & 7) * 64 + c0 + 8 * quad) * 2);
                __builtin_amdgcn_sched_barrier(0);
#pragma unroll
                for (int wi = 0; wi < 2; ++wi) { const int w4 = wb * 2 + wi;
                    u32x4 pw; pw.x = cvt_pk_bf16(s[2 * w4][0], s[2 * w4][1]); pw.y = cvt_pk_bf16(s[2 * w4][2], s[2 * w4][3]); pw.z = cvt_pk_bf16(s[2 * w4 + 1][0], s[2 * w4 + 1][1]); pw.w = cvt_pk_bf16(s[2 * w4 + 1][2], s[2 * w4 + 1][3]);
                    const bf16x8 pf = __builtin_bit_cast(bf16x8, pw);
#pragma unroll
                    for (int mt = 0; mt < 4; ++mt) o[mt] = mma_bf16(vfr[wi][mt], pf, o[mt]); }
            }
            LAS unsigned* ex = (LAS unsigned*)(lds + NAEX_OFF) + cb * 640 + lane;
            if (half == 1) {
                ex[0] = __float_as_uint(mx); ex[64] = __float_as_uint(lsum);
#pragma unroll
                for (int mt = 0; mt < 4; ++mt) { ex[(2 + 2 * mt) * 64] = pkh(o[mt][0], o[mt][1]); ex[(3 + 2 * mt) * 64] = pkh(o[mt][2], o[mt][3]); }
            }
            __syncthreads();
            if (half == 0) {
                const float m1 = __uint_as_float(ex[0]), l1 = __uint_as_float(ex[64]);
                const float m = fmaxf(mx, m1), a0 = __builtin_amdgcn_exp2f(mx - m), a1 = __builtin_amdgcn_exp2f(m1 - m);
                const float inv = 1.f / (lsum * a0 + l1 * a1);
                bf16_t* zr = Z + (size_t)(bs + r * 64 + qc) * ZW;
#pragma unroll
                for (int mt = 0; mt < 4; ++mt) {
                    const f16x2 p01 = __builtin_bit_cast(f16x2, ex[(2 + 2 * mt) * 64]), p23 = __builtin_bit_cast(f16x2, ex[(3 + 2 * mt) * 64]);
                    const float y0 = (o[mt][0] * a0 + (float)p01.x * a1) * inv, y1 = (o[mt][1] * a0 + (float)p01.y * a1) * inv;
                    const float y2 = (o[mt][2] * a0 + (float)p23.x * a1) * inv, y3 = (o[mt][3] * a0 + (float)p23.y * a1) * inv;
                    const int dcol = h * 64 + mt * 16 + quad * 4;
                    u32x2 w; w.x = cvt_pk_bf16(y0 * bf2f(gg[mt].x & 0xffffu), y1 * __uint_as_float(gg[mt].x & 0xffff0000u));
                    w.y = cvt_pk_bf16(y2 * bf2f(gg[mt].y & 0xffffu), y3 * __uint_as_float(gg[mt].y & 0xffff0000u));
                    if (mode & 8) *(u32x2*)(DUM + (size_t)(bs + r * 64 + qc) * 256 + dcol) = w; else *(u32x2*)(zr + 768 + dcol) = w;
                }
            }
        }
#undef NA_DECODE
#undef NA_ISSUE
#undef NA_KIND
    }
    __syncthreads();
    if (mode & 4) {
        const u16* YT = (const u16*)(ws + WS_ZT);
        LAS unsigned char* T = lds + wave * 8448;
        const int vcu_t = (G % 8 == 0) ? (bid % 8) * (G / 8) + bid / 8 : bid;
        for (int it = G - 1 - vcu_t; it < 384; it += G) {
            const int tile = it * 8 + wave, tb = tile >> 2, cbk = tile & 3;
            u32x4 yv[8], gv8[8];
#pragma unroll
            for (int i = 0; i < 8; ++i) { const int ch = i * 8 + (lane >> 3), k8 = lane & 7; yv[i] = *(const u32x4*)(YT + (size_t)(cbk * 64 + ch) * MTOK + tb * 64 + k8 * 8); }
#pragma unroll
            for (int i = 0; i < 8; ++i) { const int tok = i * 8 + (lane >> 3), c8 = lane & 7; gv8[i] = *(const u32x4*)(Z + (size_t)(tb * 64 + tok) * ZW + 512 + cbk * 64 + c8 * 8); }
            __builtin_amdgcn_sched_barrier(0);
#pragma unroll
            for (int i = 0; i < 8; ++i) {
                const int ch = i * 8 + (lane >> 3), k8 = lane & 7;
                LAS unsigned* d = (LAS unsigned*)(T + ch * 132 + k8 * 16);
                d[0] = yv[i].x; d[1] = yv[i].y; d[2] = yv[i].z; d[3] = yv[i].w;
            }
            asm volatile("s_waitcnt lgkmcnt(0)" ::: "memory");
#pragma unroll
            for (int i = 0; i < 8; ++i) {
                const int tok = i * 8 + (lane >> 3), c8 = lane & 7;
                bf16_t* gp = Z + (size_t)(tb * 64 + tok) * ZW + 512 + cbk * 64 + c8 * 8;
                float gt[8]; unpack8(gv8[i], gt);
                float y[8];
#pragma unroll
                for (int e = 0; e < 8; ++e) y[e] = (float)*(const LAS _Float16*)(T + (c8 * 8 + e) * 132 + tok * 2) * gt[e];
                u32x4 w; w.x = cvt_pk_bf16(y[0], y[1]); w.y = cvt_pk_bf16(y[2], y[3]); w.z = cvt_pk_bf16(y[4], y[5]); w.w = cvt_pk_bf16(y[6], y[7]);
                if (mode & 8) *(u32x4*)(DUM + (size_t)(tb * 64 + tok) * 256 + cbk * 64 + c8 * 8) = w; else *(u32x4*)gp = w;
            }
            asm volatile("s_waitcnt lgkmcnt(0)" ::: "memory");
        }
    }
    if ((mode & 16) && l + 1 < NLAYER) gen_w16(p, ws, l + 1, bid * NTHR + tid, G * NTHR);
}

#define XB_TMO      128
#define XB_XCNT(j)  (256  + 64 * (j))
#define XB_XSUB(j)  (1280 + 64 * (j))
#define XB_XGEN(j)  (2304 + 64 * (j))
#define XB_TOP      3328
#define XB_TOPGEN   3392
#define XCD_BAR_WORDS 3456
#define XB_SPIN_CAP (1u << 18)

__device__ __forceinline__ unsigned xb_ld(unsigned* p)              { return __hip_atomic_load(p, __ATOMIC_RELAXED, __HIP_MEMORY_SCOPE_AGENT); }
__device__ __forceinline__ unsigned xb_add(unsigned* p, unsigned v) { return __hip_atomic_fetch_add(p, v, __ATOMIC_RELAXED, __HIP_MEMORY_SCOPE_AGENT); }
__device__ __forceinline__ unsigned xb_xcc_id() { return (unsigned)__builtin_amdgcn_s_getreg((3 << 11) | 20) & 0xFu; }
#define XB_SPIN(cond, bar) do { unsigned _sp = 0; while (cond) { __builtin_amdgcn_s_sleep(1); \
    if ((++_sp & 255u) == 0u) { if (xb_ld(&(bar)[XB_TMO])) break; if (_sp > XB_SPIN_CAP) { atomicAdd(&(bar)[XB_TMO], 1u); break; } } } } while (0)

struct XcdBarrier {
    unsigned* bar; unsigned x;
    volatile LAS unsigned* st;
};

__device__ __forceinline__ XcdBarrier xcd_barrier_post(unsigned* bar, volatile LAS unsigned* st) {
    XcdBarrier b; b.bar = bar; b.x = xb_xcc_id(); b.st = st;
    if (threadIdx.x == 0) (void)xb_add(&bar[XB_XCNT(b.x)], 1u);
    return b;
}
__device__ __forceinline__ void xcd_barrier_complete(unsigned* bar, unsigned x, unsigned& nloc, unsigned& nx) {
    const unsigned G = gridDim.x * gridDim.y * gridDim.z;
    unsigned sum, cnt, mine, sp = 0u;
    for (;;) {
        sum = 0u; cnt = 0u; mine = 0u;
#pragma unroll
        for (unsigned j = 0; j < 16; ++j) { const unsigned c = xb_ld(&bar[XB_XCNT(j)]); sum += c; cnt += (c > 0u) ? 1u : 0u; mine = (j == x) ? c : mine; }
        if (sum == G) break;
        __builtin_amdgcn_s_sleep(1);
        if ((++sp & 255u) == 0u) { if (xb_ld(&bar[XB_TMO])) break; if (sp > XB_SPIN_CAP) { atomicAdd(&bar[XB_TMO], 1u); break; } }
    }
    nloc = mine > 0u ? mine : 1u; nx = cnt > 0u ? cnt : 1u;
}

__device__ __forceinline__ void xcd_barrier(const XcdBarrier& b) {
    asm volatile("s_waitcnt vmcnt(0)" ::: "memory");
    __syncthreads();
    if (threadIdx.x == 0) {
        unsigned* bar = b.bar;
        __builtin_amdgcn_s_waitcnt(0);
        unsigned nloc = b.st[0], nx = b.st[1];
        if (nloc == 0u) { xcd_barrier_complete(bar, b.x, nloc, nx); b.st[0] = nloc; b.st[1] = nx; }
        const unsigned old = xb_add(&bar[XB_XSUB(b.x)], 1u);
        const unsigned gen = old / nloc;
        if (old + 1u == (gen + 1u) * nloc) {
            __builtin_amdgcn_fence(__ATOMIC_RELEASE, "agent");
            asm volatile("s_waitcnt vmcnt(0)" ::: "memory");
            const unsigned og = xb_add(&bar[XB_TOP], 1u);
            const unsigned tg = og / nx;
            if (og + 1u == (tg + 1u) * nx) xb_add(&bar[XB_TOPGEN], 1u);
            else XB_SPIN(xb_ld(&bar[XB_TOPGEN]) == tg, bar);
            __builtin_amdgcn_fence(__ATOMIC_ACQUIRE, "agent");
            xb_add(&bar[XB_XGEN(b.x)], 1u);
            asm volatile("s_waitcnt vmcnt(0)" ::: "memory");
        } else {
            XB_SPIN(xb_ld(&bar[XB_XGEN(b.x)]) == gen, bar);
            __builtin_amdgcn_fence(__ATOMIC_ACQUIRE, "agent");
            asm volatile("s_waitcnt vmcnt(0)" ::: "memory");
        }
    }
    __syncthreads();
}

#ifndef PHM
#define PHM 127
#endif
#ifndef DUP
#define DUP 0
#endif
__global__ void __launch_bounds__(NTHR, 2) hpge_fwd(Params p) {
    extern __shared__ __attribute__((aligned(16))) unsigned char lds_raw[];
    LAS unsigned char* lds = (LAS unsigned char*)lds_raw;
    const int tid = threadIdx.x, lane = tid & 63, wave = __builtin_amdgcn_readfirstlane(tid >> 6);
    const int bid = blockIdx.x, G = gridDim.x;
    unsigned char* ws = p.ws;
    const int lo = p.ph_lo, hi = p.ph_hi;
    const bool coop = (hi - lo) > 1;
#define IN(k) (lo <= (k) && (k) < hi)
    volatile LAS unsigned* MISC = (volatile LAS unsigned*)(lds + LDS_BYTES - 64);
    if (tid < 16) MISC[tid] = 0u;
    __syncthreads();
    XcdBarrier bar; bar.bar = (unsigned*)ws; bar.x = 0; bar.st = nullptr;
    if (coop) bar = xcd_barrier_post((unsigned*)ws, MISC);
    if (hi > NPHASE) { __threadfence(); cg::this_grid().sync(); }
#define SEAM(k) do { if (coop && IN(k) && IN((k) + 1)) { xcd_barrier(bar); if (DUP & 1) xcd_barrier(bar); } } while (0)
    if (IN(0) && (PHM & 1)) { phase_p0a(p, lds, bid, G, tid, lane, wave); if (DUP & 2) { __syncthreads(); phase_p0a(p, lds, bid, G, tid, lane, wave); } }
    SEAM(0);
    if (IN(1) && (PHM & 2)) { phase_p0b(p, lds, bid, G, tid, lane, wave); if (DUP & 512) { __syncthreads(); phase_p0b(p, lds, bid, G, tid, lane, wave); } }
    SEAM(1);
#pragma unroll 1
    for (int l = 0; l < NLAYER; ++l) {
        const int pb = 2 + 4 * l;
        if (IN(pb) && (PHM & 4)) {
            __syncthreads();
            pg8::Gemm g{(const bf16_t*)(ws + WS_X16), (const bf16_t*)(ws + WS_W16), MTOK, NIN, D, D, D, 0xE00u, (size_t)NIN * D * 2};
            pg8::StaticOrder S; S.init(MTOK, NIN, G, bid);
            Epi1 E{(bf16_t*)(ws + WS_Z), (u16*)(ws + WS_ZT), (const float*)(ws + WS_SSQ), (const float*)(ws + WS_SB) + (size_t)l * NB * NIN, 0};
            if (DUP & 4) { E.noact = 2; pg8::gemm_phase<Epi1, pg8::StaticOrder, true, true, true>(lds, g, S, E); E.noact = 0; __syncthreads(); xcd_barrier(bar); }
            pg8::gemm_phase<Epi1, pg8::StaticOrder, true, true, true>(lds, g, S, E);
        }
        SEAM(pb);
        if (IN(pb + 1) && (PHM & 8)) { phase_p2a(p, lds, bid, G, tid, lane, wave); if (DUP & 8) phase_p2a(p, lds, bid, G, tid, lane, wave, 1); if (DUP & 16) phase_p2a(p, lds, bid, G, tid, lane, wave, 6); }
        SEAM(pb + 1);
        if (IN(pb + 2) && (PHM & 16)) { phase_p2b(p, lds, l, bid, G, tid, lane, wave); if (DUP & 32) phase_p2b(p, lds, l, bid, G, tid, lane, wave, 9); if (DUP & 64) phase_p2b(p, lds, l, bid, G, tid, lane, wave, 10); if (DUP & 128) phase_p2b(p, lds, l, bid, G, tid, lane, wave, 12); }
        SEAM(pb + 2);
        if (IN(pb + 3) && (PHM & 32)) {
            __syncthreads();
            pg8::Gemm g{(const bf16_t*)(ws + WS_Z), (const bf16_t*)(ws + WS_WOUT) + (size_t)l * D * D, MTOK, D, D, ZW, D, 0u, 0};
            pg8::StaticOrder S; S.init(MTOK, D, G, bid);
            Epi2 E{(u16*)(ws + WS_X16), (float*)(ws + WS_SSQ), (const float*)(ws + WS_MOD) + (size_t)l * NB * 3072 + 2048, 1.f};
            if (DUP & 1024) { E.gscale = 0.f; E.ssq = (float*)(ws + WS_END); pg8::gemm_phase<Epi2, pg8::StaticOrder, true, true>(lds, g, S, E); E.gscale = 1.f; E.ssq = (float*)(ws + WS_SSQ); __syncthreads(); }
            pg8::gemm_phase<Epi2, pg8::StaticOrder, true, true>(lds, g, S, E);
            if (l + 1 < NLAYER) gen_w16(p, ws, l + 1, bid * NTHR + tid, G * NTHR);
        }
        SEAM(pb + 3);
    }
    if (IN(NPHASE - 1) && (PHM & 64)) { phase_final(p, bid, G, lane, wave); }
#undef IN
#undef SEAM
}

#ifndef HPGE_MULTI
#define HPGE_MULTI 0
#endif
extern "C" void kernel_launch(void* const* d_in, const int* in_sizes, int n_in, void* d_out, int out_size, void* d_ws, size_t ws_size, hipStream_t stream) {
    static int grid = 0;
    if (grid == 0) {
        if (n_in != 17 || out_size != MTOK * D || ws_size < WS_END) { fprintf(stderr, "kernel_launch: unexpected shapes (n_in %d out %d ws %zu)\n", n_in, out_size, ws_size); grid = -1; return; }
        int dev = 0, cus = 0, per_cu = 0;
        (void)hipGetDevice(&dev); (void)hipDeviceGetAttribute(&cus, hipDeviceAttributeMultiprocessorCount, dev);
        if (hipFuncSetAttribute((const void*)hpge_fwd, hipFuncAttributeMaxDynamicSharedMemorySize, LDS_BYTES) != hipSuccess) { fprintf(stderr, "kernel_launch: hipFuncSetAttribute failed\n"); grid = -1; return; }
        if (hipOccupancyMaxActiveBlocksPerMultiprocessor(&per_cu, (const void*)hpge_fwd, NTHR, LDS_BYTES) != hipSuccess || per_cu < 1) { fprintf(stderr, "kernel_launch: occupancy query gave %d\n", per_cu); per_cu = 1; }
        (void)hipGetLastError();
        grid = cus * (per_cu > 1 ? 1 : per_cu);
        if (grid <= 0) grid = 256;
    }
    if (grid < 0) return;
    if (hipMemsetAsync(d_ws, 0, 16384, stream) != hipSuccess) { fprintf(stderr, "kernel_launch: memset failed\n"); return; }
    Params p{};
    for (int i = 0; i < 17; ++i) p.in[i] = (const float*)d_in[i];
    p.out = (float*)d_out; p.ws = (unsigned char*)d_ws;
#if HPGE_MULTI
    for (int k = 0; k < NPHASE; ++k) { p.ph_lo = k; p.ph_hi = k + 1; hipLaunchKernelGGL(hpge_fwd, dim3(grid), dim3(NTHR), LDS_BYTES, stream, p); }
#else
    p.ph_lo = 0; p.ph_hi = NPHASE;
    void* args[] = {&p};
    const hipError_t e = hipLaunchCooperativeKernel((const void*)hpge_fwd, dim3(grid), dim3(NTHR), args, LDS_BYTES, stream);
    if (e != hipSuccess) fprintf(stderr, "kernel_launch: cooperative launch failed: %s (grid %d)\n", hipGetErrorString(e), grid);
#endif
}
```

```cpp
#include <hip/hip_runtime.h>
#include <hip/hip_cooperative_groups.h>
#include <cstdio>
#include <cstdint>
namespace cg = cooperative_groups;
namespace pg8 {
#define PG8_LAS __attribute__((address_space(3)))
typedef unsigned short bf16_t;
typedef short bf16x8 __attribute__((ext_vector_type(8)));
typedef float f32x4 __attribute__((ext_vector_type(4)));
typedef unsigned u32x4 __attribute__((ext_vector_type(4)));
constexpr int BM = 256, BK = 64, HALF = 128, HTB = HALF * BK * 2  , STAGE_BYTES = 8 * HTB, NXCD = 8, WGM = 8;

__host__ __device__ __forceinline__ int lds_byte(int r, int c) { const int st = (r >> 4) * 2 + (c >> 5), rr = r & 15, cc = c & 31, ob = rr * 64 + cc * 2; return st * 1024 + (ob ^ (((ob >> 9) & 1) << 5)); }
__host__ __device__ __forceinline__ void stage_rc(int b, int& R, int& C) { const int st = b / 1024, sb = b % 1024, swz = sb ^ (((sb >> 9) & 1) << 5); R = (st >> 1) * 16 + swz / 64; C = (st & 1) * 32 + (swz % 64) / 2; }
__host__ __device__ __forceinline__ int perm32(int rho) { const int n = rho >> 4, i = rho & 15; return 8 * (i >> 2) + 4 * n + (i & 3); }

struct Unit { int pm, pn; };
struct Gemm { const bf16_t* A; const bf16_t* Bt; int M, N, K, ldA, ldB; unsigned tmask; size_t bstride; };
__device__ __forceinline__ void unit_ptrs(const Gemm& g, const Unit& u, size_t tsA, size_t tsB, const char*& a, const char*& b) {
    const int bt = u.pm < 64 ? (u.pm >> 3) : 8 + ((u.pm - 64) >> 6);
    const char* w = (const char*)g.Bt + (size_t)bt * g.bstride + (size_t)u.pn * tsB;
    if ((g.tmask >> u.pn) & 1u) { a = w; b = (const char*)g.A + (size_t)u.pm * tsA; }
    else { a = (const char*)g.A + (size_t)u.pm * tsA; b = w; }
}
typedef _Float16 f16x8_t __attribute__((ext_vector_type(8)));
template <bool F16> __device__ __forceinline__ f32x4 mma16(bf16x8 a, bf16x8 b, f32x4 c) {
    if constexpr (F16) return __builtin_amdgcn_mfma_f32_16x16x32_f16(__builtin_bit_cast(f16x8_t, a), __builtin_bit_cast(f16x8_t, b), c, 0, 0, 0);
    else return __builtin_amdgcn_mfma_f32_16x16x32_bf16(a, b, c, 0, 0, 0);
}

struct StaticOrder {
    int nM, nN, nwg, G, c;
    __host__ __device__ void init(int M, int N, int G_, int c_) { nM = M / BM; nN = N / BM; nwg = nM * nN; G = G_; c = c_; }
    __host__ __device__ bool next(int i, Unit& u) const {
        const long L = (long)i * G + c; if (L >= nwg) return false;
        int wgid = (int)L; { const int q = nwg / NXCD, r = nwg % NXCD, xcd = wgid % NXCD, off = wgid / NXCD; wgid = (xcd < r ? xcd * (q + 1) : r * (q + 1) + (xcd - r) * q) + off; }
        const int nig = WGM * nN, gid = wgid / nig, fm = gid * WGM, gsz = (nM - fm) < WGM ? (nM - fm) : WGM;
        u.pm = fm + ((wgid % nig) % gsz); u.pn = (wgid % nig) / gsz; return true;
    }
    __device__ __forceinline__ void a_ready(const Unit&) const {}
    __device__ __forceinline__ void done(const Unit&) const {}
};
typedef float f32x2_t __attribute__((ext_vector_type(2))); typedef __bf16 bf16x2_t __attribute__((ext_vector_type(2)));
__device__ __forceinline__ unsigned cvt_pk_bf16(float lo, float hi) { f32x2_t v = {lo, hi}; bf16x2_t b = __builtin_convertvector(v, bf16x2_t); return __builtin_bit_cast(unsigned, b); }

template <class Epi, class Sched, bool ALIGN_EPI = false, bool SP2 = false, bool F16 = false>
__device__ __forceinline__ void gemm_phase(PG8_LAS unsigned char* lds, const Gemm g, const Sched& S, const Epi& E) {
    int tid = threadIdx.x; asm volatile("" : "+v"(tid));
    const int wid = __builtin_amdgcn_readfirstlane(tid >> 6), lane = tid & 63, wr = wid >> 2, wc = wid & 3, fr = lane & 15, fq = lane >> 4;
    const int K = g.K, nt = K / BK;
    unsigned voffA[2], voffB[2];
#pragma unroll
    for (int i = 0; i < 2; ++i) { int R, C; stage_rc(tid * 16 + i * 8192, R, C); const int Rb = Epi::PERM ? ((R & ~31) + perm32(R & 31)) : R;
        voffA[i] = (unsigned)(R * g.ldA + C) * 2u; voffB[i] = (unsigned)(Rb * g.ldB + C) * 2u; }
    const size_t kstep = (size_t)(BK * 2);
    const size_t hsA = (size_t)HALF * g.ldA * 2, hsB = (size_t)HALF * g.ldB * 2;
    const size_t tsA = 2 * hsA, tsB = 2 * hsB;
    const unsigned ldsw = (unsigned)wid * 1024u;
    const int aoff = lds_byte(wr * 64 + fr, fq * 8), boff = lds_byte(wc * 32 + fr, fq * 8);
#define PG8_SA(b, h) (((b) * 2 + (h)) * HTB)
#define PG8_SB(b, h) ((4 + (b) * 2 + (h)) * HTB)
#define PG8_STAGE(bufoff, gbase, voff) do { _Pragma("unroll") for (int _i = 0; _i < 2; ++_i) \
        __builtin_amdgcn_global_load_lds((const unsigned*)((const char*)(gbase) + (voff)[_i]), (PG8_LAS unsigned*)(lds + (bufoff) + ldsw + _i * 8192), 16, 0, 0); } while (0)
#define PG8_LDA(dst, b, h) do { _Pragma("unroll") for (int m = 0; m < 4; ++m) _Pragma("unroll") for (int k = 0; k < 2; ++k) dst[m][k] = *(const PG8_LAS bf16x8*)(lds + PG8_SA(b, h) + aoff + m * 2048 + k * 1024); } while (0)
#define PG8_LDB(dst, b, h) do { _Pragma("unroll") for (int n = 0; n < 2; ++n) _Pragma("unroll") for (int k = 0; k < 2; ++k) dst[n][k] = *(const PG8_LAS bf16x8*)(lds + PG8_SB(b, h) + boff + n * 2048 + k * 1024); } while (0)
#define PG8_MMA(ai, bj, At, Bt) do { __builtin_amdgcn_s_setprio(1); _Pragma("unroll") for (int m = 0; m < 4; ++m) _Pragma("unroll") for (int n = 0; n < 2; ++n) _Pragma("unroll") for (int k = 0; k < 2; ++k) \
        acc[ai][bj][m][n] = mma16<F16>(Bt[n][k], At[m][k], acc[ai][bj][m][n]); __builtin_amdgcn_s_setprio(0); } while (0)
#define PG8_WAIT_V(n) asm volatile("s_waitcnt vmcnt(" #n ")" ::: "memory")
#define PG8_WAIT_L(n) asm volatile("s_waitcnt lgkmcnt(" #n ")" ::: "memory")
#define PG8_BAR __builtin_amdgcn_s_barrier()
#define PG8_SCHED __builtin_amdgcn_sched_barrier(0)
    Unit cur, nxt; int ui = 0;
    typename Epi::Pre pre;
    if (!S.next(0, cur)) return;
    f32x4 acc[2][2][4][2];
#pragma unroll
    for (int a = 0; a < 2; ++a)
#pragma unroll
        for (int b = 0; b < 2; ++b)
#pragma unroll
            for (int m = 0; m < 4; ++m)
#pragma unroll
                for (int n = 0; n < 2; ++n) acc[a][b][m][n] = (f32x4){0.f, 0.f, 0.f, 0.f};
    bf16x8 At[4][2], B0[2][2], B1[2][2];
    const char* cA; const char* cB; unit_ptrs(g, cur, tsA, tsB, cA, cB);
    S.a_ready(cur);
    if constexpr (SP2) {
        PG8_STAGE(PG8_SB(0, 0), cB, voffB); PG8_STAGE(PG8_SB(0, 1), cB + hsB, voffB); PG8_STAGE(PG8_SA(0, 0), cA, voffA); PG8_STAGE(PG8_SA(0, 1), cA + hsA, voffA);
        if (wr == 1) PG8_BAR;
        PG8_WAIT_V(2); PG8_BAR;
        PG8_STAGE(PG8_SB(1, 0), cB + kstep, voffB); PG8_STAGE(PG8_SA(1, 0), cA + kstep, voffA); PG8_STAGE(PG8_SB(1, 1), cB + hsB + kstep, voffB);
        PG8_WAIT_V(6); PG8_BAR;
    } else {
        PG8_STAGE(PG8_SB(0, 0), cB, voffB); PG8_STAGE(PG8_SA(0, 0), cA, voffA); PG8_STAGE(PG8_SB(0, 1), cB + hsB, voffB); PG8_STAGE(PG8_SA(0, 1), cA + hsA, voffA);
        if (wr == 1) PG8_BAR;
        PG8_WAIT_V(4); PG8_BAR;
        PG8_STAGE(PG8_SB(1, 0), cB + kstep, voffB); PG8_STAGE(PG8_SA(1, 0), cA + kstep, voffA); PG8_STAGE(PG8_SB(1, 1), cB + hsB + kstep, voffB);
        PG8_WAIT_V(6); PG8_BAR;
    }
    for (;;) {
        const bool has_next = S.next(ui + 1, nxt);
        const char* nA = cA; const char* nB = cB; if (has_next) unit_ptrs(g, nxt, tsA, tsB, nA, nB);
        for (int t = 0; t < nt; t += 2) {
            const bool last = (t == nt - 2);
            const char* a1 = cA + (size_t)(t + 1) * kstep;
            const char* a2 = last ? nA : cA + (size_t)(t + 2) * kstep; const char* b2 = last ? nB : cB + (size_t)(t + 2) * kstep;
            const char* a3 = a2 + kstep; const char* b3 = b2 + kstep;
            if (last && has_next) S.a_ready(nxt);
            if (last) E.prefetch(pre, cur, wr, wc, fr, fq);
            if constexpr (SP2) {
            PG8_LDB(B0, 0, 0); PG8_LDB(B1, 0, 1); PG8_SCHED; PG8_LDA(At, 0, 0); PG8_STAGE(PG8_SA(1, 1), a1 + hsA, voffA);
            PG8_WAIT_V(8); PG8_WAIT_L(0); PG8_BAR; PG8_MMA(0, 0, At, B0); PG8_MMA(0, 1, At, B1); PG8_BAR; PG8_SCHED;
            PG8_LDA(At, 0, 1); PG8_STAGE(PG8_SB(0, 0), b2, voffB); PG8_STAGE(PG8_SB(0, 1), b2 + hsB, voffB); PG8_STAGE(PG8_SA(0, 0), a2, voffA);
            PG8_WAIT_V(8); PG8_WAIT_L(0); PG8_BAR; PG8_MMA(1, 0, At, B0); PG8_MMA(1, 1, At, B1); PG8_BAR; PG8_SCHED;
            PG8_LDB(B0, 1, 0); PG8_LDB(B1, 1, 1); PG8_SCHED; PG8_LDA(At, 1, 0); PG8_STAGE(PG8_SA(0, 1), a2 + hsA, voffA);
            PG8_WAIT_V(8); PG8_WAIT_L(0); PG8_BAR; PG8_MMA(0, 0, At, B0); PG8_MMA(0, 1, At, B1); PG8_BAR; PG8_SCHED;
            PG8_LDA(At, 1, 1); PG8_STAGE(PG8_SB(1, 0), b3, voffB); PG8_STAGE(PG8_SB(1, 1), b3 + hsB, voffB); PG8_STAGE(PG8_SA(1, 0), a3, voffA);
            PG8_WAIT_V(8); PG8_WAIT_L(0); PG8_BAR; PG8_MMA(1, 0, At, B0); PG8_MMA(1, 1, At, B1); PG8_BAR; PG8_SCHED;
            } else {
            PG8_LDB(B0, 0, 0); PG8_SCHED; PG8_LDA(At, 0, 0); PG8_STAGE(PG8_SA(1, 1), a1 + hsA, voffA);
            PG8_WAIT_L(8); PG8_BAR; PG8_WAIT_L(0); PG8_MMA(0, 0, At, B0); PG8_BAR; PG8_SCHED;
            PG8_LDB(B1, 0, 1); PG8_STAGE(PG8_SB(0, 0), b2, voffB);
            PG8_BAR; PG8_WAIT_L(0); PG8_MMA(0, 1, At, B1); PG8_BAR;
            PG8_LDA(At, 0, 1); PG8_STAGE(PG8_SA(0, 0), a2, voffA);
            PG8_BAR; PG8_WAIT_L(0); PG8_MMA(1, 0, At, B0); PG8_BAR; PG8_SCHED;
            PG8_STAGE(PG8_SB(0, 1), b2 + hsB, voffB);
            PG8_WAIT_V(6); PG8_BAR; PG8_MMA(1, 1, At, B1); PG8_BAR;
            PG8_LDB(B0, 1, 0); PG8_SCHED; PG8_LDA(At, 1, 0); PG8_STAGE(PG8_SA(0, 1), a2 + hsA, voffA);
            PG8_WAIT_L(8); PG8_BAR; PG8_WAIT_L(0); PG8_MMA(0, 0, At, B0); PG8_BAR; PG8_SCHED;
            PG8_LDB(B1, 1, 1); PG8_STAGE(PG8_SB(1, 0), b3, voffB);
            PG8_BAR; PG8_WAIT_L(0); PG8_MMA(0, 1, At, B1); PG8_BAR;
            PG8_LDA(At, 1, 1); PG8_STAGE(PG8_SA(1, 0), a3, voffA);
            PG8_BAR; PG8_WAIT_L(0); PG8_MMA(1, 0, At, B0); PG8_BAR; PG8_SCHED;
            PG8_STAGE(PG8_SB(1, 1), b3 + hsB, voffB);
            PG8_WAIT_V(6); PG8_BAR; PG8_MMA(1, 1, At, B1); PG8_BAR;
            }
        }
        if constexpr (ALIGN_EPI) { if (wr == 0) PG8_BAR; }
        if constexpr (!Epi::AFTER_DRAIN) { E(acc, cur, wr, wc, fr, fq, pre); S.done(cur); }
        if (!has_next) break;
#pragma unroll
        for (int a = 0; a < 2; ++a)
#pragma unroll
            for (int b = 0; b < 2; ++b)
#pragma unroll
                for (int m = 0; m < 4; ++m)
#pragma unroll
                    for (int n = 0; n < 2; ++n) acc[a][b][m][n] = (f32x4){0.f, 0.f, 0.f, 0.f};
        cur = nxt; cA = nA; cB = nB; ++ui;
        if constexpr (ALIGN_EPI) { if (wr == 1) PG8_BAR; }
    }
    PG8_WAIT_V(0);
    if constexpr (!ALIGN_EPI) { if (wr == 0) PG8_BAR; }
    PG8_BAR;
    if constexpr (Epi::AFTER_DRAIN) { E.fused(acc, cur, wr, wc, fr, fq, lds, wid, lane); S.done(cur); }
#undef PG8_SA
#undef PG8_SB
#undef PG8_STAGE
#undef PG8_LDA
#undef PG8_LDB
#undef PG8_MMA
#undef PG8_WAIT_V
#undef PG8_WAIT_L
#undef PG8_BAR
#undef PG8_SCHED
}
}

using pg8::bf16_t; using pg8::f32x4; using pg8::u32x4; using pg8::bf16x8; using pg8::cvt_pk_bf16;
#define LAS __attribute__((address_space(3)))
typedef _Float16 f16x8 __attribute__((ext_vector_type(8)));
typedef _Float16 f16x4 __attribute__((ext_vector_type(4)));
typedef _Float16 f16x2 __attribute__((ext_vector_type(2)));
typedef short s16x4 __attribute__((ext_vector_type(4)));
typedef unsigned u32x2 __attribute__((ext_vector_type(2)));
typedef float f32x2 __attribute__((ext_vector_type(2)));
typedef unsigned short u16;

constexpr int D = 1024, MTOK = 49152, NB = 10, NLAYER = 4, ZW = 2304, NIN = 3072, DIN = 2816, NPT = 16384;
constexpr float RMS_EPS = 1e-6f, LN_EPS = 1e-5f;
constexpr int NTHR = 512;
constexpr int LDS_BYTES = 158720;
constexpr int NPHASE = 2 + 4 * NLAYER + 1;

constexpr size_t MiB = 1u << 20;
constexpr size_t WS_WIN = 1 * MiB;
constexpr size_t WS_WOUT = 25 * MiB;
constexpr size_t WS_SGUW = 33 * MiB;
constexpr size_t WS_MOD = 34 * MiB;
constexpr size_t WS_SB = 35 * MiB;
constexpr size_t WS_GM = 36 * MiB;
constexpr size_t WS_SSQ = 37 * MiB;
constexpr size_t WS_DFT = 38 * MiB;
constexpr size_t WS_X16 = 40 * MiB;
constexpr size_t WS_Z = 136 * MiB;
constexpr size_t WS_ZT = 352 * MiB;
constexpr size_t WS_W16 = 424 * MiB;
constexpr size_t WS_END = 484 * MiB;
constexpr size_t DF_C128 = 0, DF_S128 = 32768, DF_NS128 = 65536, DF_T1 = 98304, DF_T2 = 99328, DF_TW16K = 102400, DF_TW2K = 233472;

struct Params { const float* in[17]; float* out; unsigned char* ws; int ph_lo, ph_hi; };

__device__ __forceinline__ int batch_of_tile(int pm) { return pm < 64 ? (pm >> 3) : 8 + ((pm - 64) >> 6); }
__device__ __forceinline__ int batch_of_tok(int t) { return t < NPT ? (t >> 11) : 8 + ((t - NPT) >> 14); }
__device__ __forceinline__ float bf2f(unsigned h) { return __uint_as_float(h << 16); }
__device__ __forceinline__ unsigned f2bf(float f) { unsigned u = __float_as_uint(f); return (u + 0x7fffu + ((u >> 16) & 1u)) >> 16; }
__device__ __forceinline__ float sigm(float x) { return __builtin_amdgcn_rcpf(1.f + __expf(-x)); }
__device__ __forceinline__ float silu_(float v) { return v * sigm(v); }
__device__ __forceinline__ float gelu_(float v) { return v * sigm(1.5957691216f * (v + 0.044715f * v * v * v)); }
__device__ __forceinline__ unsigned pkh(float a, float b) { f16x2 h; h.x = (_Float16)a; h.y = (_Float16)b; return __builtin_bit_cast(unsigned, h); }
__device__ __forceinline__ float wave_sum(float v) {
#pragma unroll
    for (int o = 1; o < 64; o <<= 1) v += __shfl_xor(v, o);
    return v;
}
__device__ __forceinline__ void unpack8(const u32x4 v, float (&f)[8]) {
    f[0] = bf2f(v.x & 0xffffu); f[1] = __uint_as_float(v.x & 0xffff0000u); f[2] = bf2f(v.y & 0xffffu); f[3] = __uint_as_float(v.y & 0xffff0000u);
    f[4] = bf2f(v.z & 0xffffu); f[5] = __uint_as_float(v.z & 0xffff0000u); f[6] = bf2f(v.w & 0xffffu); f[7] = __uint_as_float(v.w & 0xffff0000u);
}
__device__ __forceinline__ float quad_max(float x) {
    auto a = __builtin_amdgcn_permlane16_swap(__float_as_uint(x), __float_as_uint(x), false, false); x = fmaxf(__uint_as_float(a[0]), __uint_as_float(a[1]));
    auto b = __builtin_amdgcn_permlane32_swap(__float_as_uint(x), __float_as_uint(x), false, false); return fmaxf(__uint_as_float(b[0]), __uint_as_float(b[1]));
}
__device__ __forceinline__ float quad_sum(float x) {
    auto a = __builtin_amdgcn_permlane16_swap(__float_as_uint(x), __float_as_uint(x), false, false); x = __uint_as_float(a[0]) + __uint_as_float(a[1]);
    auto b = __builtin_amdgcn_permlane32_swap(__float_as_uint(x), __float_as_uint(x), false, false); return __uint_as_float(b[0]) + __uint_as_float(b[1]);
}
typedef short v4i16_t __attribute__((ext_vector_type(4)));
__device__ __forceinline__ bf16x8 tr_frag(LAS const unsigned char* base, int pitch, int row0, int col0, int lane) {
    const int i16 = lane & 15;
    LAS const unsigned char* p = base + (row0 + (i16 >> 2)) * pitch + (col0 + 4 * (i16 & 3)) * 2;
    const v4i16_t lo = __builtin_amdgcn_ds_read_tr16_b64_v4i16((LAS v4i16_t*)p);
    const v4i16_t hi = __builtin_amdgcn_ds_read_tr16_b64_v4i16((LAS v4i16_t*)(p + 4 * pitch));
    bf16x8 r; r[0] = lo[0]; r[1] = lo[1]; r[2] = lo[2]; r[3] = lo[3]; r[4] = hi[0]; r[5] = hi[1]; r[6] = hi[2]; r[7] = hi[3]; return r;
}
__device__ __forceinline__ f32x4 mma_bf16(bf16x8 a, bf16x8 b, f32x4 c) { return __builtin_amdgcn_mfma_f32_16x16x32_bf16(a, b, c, 0, 0, 0); }
__device__ __forceinline__ f32x4 mma_f16(bf16x8 a, bf16x8 b, f32x4 c) { return __builtin_amdgcn_mfma_f32_16x16x32_f16(__builtin_bit_cast(f16x8, a), __builtin_bit_cast(f16x8, b), c, 0, 0, 0); }

struct Epi1 {
    static constexpr bool PERM = true, AFTER_DRAIN = false;
    bf16_t* Z; u16* ZT; const float* ssq; const float* sb; int noact;
    struct Pre { float v[4]; };
    __device__ __forceinline__ void prefetch(Pre& q, const pg8::Unit& u, int wr, int wc, int fr, int fq) const {
        const int b = batch_of_tile(u.pm);
        if (u.pn < 9) { const int row0 = u.pm * 256 + wr * 64 + fr;
#pragma unroll
            for (int i = 0; i < 4; ++i) q.v[i] = ssq[row0 + i * 16];
        } else { const int chr0 = wr * 64 + fr;
#pragma unroll
            for (int i = 0; i < 4; ++i) q.v[i] = sb[b * NIN + u.pn * 256 + chr0 + i * 16]; }
    }
    __device__ __forceinline__ void operator()(const f32x4 (&acc)[2][2][4][2], const pg8::Unit& u, int wr, int wc, int fr, int fq, const Pre& pq) const {
        if (noact == 2) {
#pragma unroll
            for (int ai = 0; ai < 2; ++ai)
#pragma unroll
                for (int bj = 0; bj < 2; ++bj)
#pragma unroll
                    for (int m = 0; m < 4; ++m)
#pragma unroll
                        for (int n = 0; n < 2; ++n) asm volatile("" :: "v"(acc[ai][bj][m][n]));
            return; }
        const int b = batch_of_tile(u.pm);
        if (u.pn < 9) {
            const int act = noact ? 0 : (0x11819u >> (2 * u.pn)) & 3;
            const int row0 = u.pm * 256 + wr * 64 + fr, colt = u.pn * 256 + wc * 32 + 8 * fq;
            f32x4 bv[2][2];
#pragma unroll
            for (int bj = 0; bj < 2; ++bj)
#pragma unroll
                for (int n = 0; n < 2; ++n) bv[bj][n] = *(const f32x4*)(sb + b * NIN + colt + bj * 128 + 4 * n);
            float sq[2][4];
#pragma unroll
            for (int ai = 0; ai < 2; ++ai)
#pragma unroll
                for (int m = 0; m < 4; ++m) sq[ai][m] = ai == 0 ? pq.v[m] : ssq[row0 + 128 + m * 16];
#pragma unroll
            for (int ai = 0; ai < 2; ++ai)
#pragma unroll
                for (int m = 0; m < 4; ++m) {
                    const int row = row0 + ai * 128 + m * 16;
                    const float rs = __builtin_amdgcn_rsqf(sq[ai][m] * (1.f / 1024.f) + RMS_EPS);
                    bf16_t* rowp = Z + (size_t)row * ZW + colt;
#pragma unroll
                    for (int bj = 0; bj < 2; ++bj) {
                        f32x4 v0 = acc[ai][bj][m][0] * rs + bv[bj][0], v1 = acc[ai][bj][m][1] * rs + bv[bj][1];
                        if (act == 1) {
#pragma unroll
                            for (int e = 0; e < 4; ++e) { v0[e] = silu_(v0[e]); v1[e] = silu_(v1[e]); }
                        } else if (act == 2) {
#pragma unroll
                            for (int e = 0; e < 4; ++e) { v0[e] = gelu_(v0[e]); v1[e] = gelu_(v1[e]); }
                        }
                        u32x4 w; w.x = cvt_pk_bf16(v0[0], v0[1]); w.y = cvt_pk_bf16(v0[2], v0[3]); w.z = cvt_pk_bf16(v1[0], v1[1]); w.w = cvt_pk_bf16(v1[2], v1[3]);
                        *(u32x4*)(rowp + bj * 128) = w;
                    }
                }
        } else {
            const int chr0 = wr * 64 + fr, tok0 = u.pm * 256 + wc * 32 + 8 * fq, zr = (u.pn - 9) * 256;
            const bool f16out = u.pn != 11;
            f32x4 rv[2][2];
#pragma unroll
            for (int bj = 0; bj < 2; ++bj)
#pragma unroll
                for (int n = 0; n < 2; ++n) { const f32x4 s = *(const f32x4*)(ssq + tok0 + bj * 128 + 4 * n);
#pragma unroll
                    for (int e = 0; e < 4; ++e) rv[bj][n][e] = __builtin_amdgcn_rsqf(s[e] * (1.f / 1024.f) + RMS_EPS); }
            float bs8[2][4];
#pragma unroll
            for (int ai = 0; ai < 2; ++ai)
#pragma unroll
                for (int m = 0; m < 4; ++m) bs8[ai][m] = ai == 0 ? pq.v[m] : sb[b * NIN + u.pn * 256 + chr0 + 128 + m * 16];
#pragma unroll
            for (int ai = 0; ai < 2; ++ai)
#pragma unroll
                for (int m = 0; m < 4; ++m) {
                    const int ch = chr0 + ai * 128 + m * 16;
                    const float bias = bs8[ai][m];
                    u16* rowp = ZT + (size_t)(zr + ch) * MTOK + tok0;
#pragma unroll
                    for (int bj = 0; bj < 2; ++bj) {
                        const f32x4 v0 = acc[ai][bj][m][0] * rv[bj][0] + bias, v1 = acc[ai][bj][m][1] * rv[bj][1] + bias;
                        u32x4 w;
                        if (f16out) { w.x = pkh(v0[0], v0[1]); w.y = pkh(v0[2], v0[3]); w.z = pkh(v1[0], v1[1]); w.w = pkh(v1[2], v1[3]); }
                        else { w.x = cvt_pk_bf16(v0[0], v0[1]); w.y = cvt_pk_bf16(v0[2], v0[3]); w.z = cvt_pk_bf16(v1[0], v1[1]); w.w = cvt_pk_bf16(v1[2], v1[3]); }
                        *(u32x4*)(rowp + bj * 128) = w;
                    }
                }
        }
    }
};
struct Epi2 {
    static constexpr bool PERM = true, AFTER_DRAIN = false;
    u16* X16; float* ssq; const float* gate; float gscale;
    struct Pre { u32x4 x0[2]; };
    __device__ __forceinline__ void prefetch(Pre& q, const pg8::Unit& u, int wr, int wc, int fr, int fq) const {
        const u16* xr = X16 + (size_t)(u.pm * 256 + wr * 64 + fr) * D + u.pn * 256 + wc * 32 + 8 * fq; q.x0[0] = *(const u32x4*)xr; q.x0[1] = *(const u32x4*)(xr + 128); }
    __device__ __forceinline__ void operator()(const f32x4 (&acc)[2][2][4][2], const pg8::Unit& u, int wr, int wc, int fr, int fq, const Pre& pq) const {
        const int b = batch_of_tile(u.pm);
        const int row0 = u.pm * 256 + wr * 64 + fr, col0 = u.pn * 256 + wc * 32 + 8 * fq;
        f32x4 gv[2][2];
#pragma unroll
        for (int bj = 0; bj < 2; ++bj)
#pragma unroll
            for (int n = 0; n < 2; ++n) gv[bj][n] = *(const f32x4*)(gate + b * NIN + col0 + bj * 128 + 4 * n) * gscale;
        u32x4 xv[5][2];
#define E2_LOAD(k) do { u16* xr = X16 + (size_t)(row0 + ((k) >> 2) * 128 + ((k) & 3) * 16) * D + col0; xv[(k) % 5][0] = *(const u32x4*)xr; xv[(k) % 5][1] = *(const u32x4*)(xr + 128); } while (0)
        xv[0][0] = pq.x0[0]; xv[0][1] = pq.x0[1]; E2_LOAD(1); E2_LOAD(2); E2_LOAD(3);
#pragma unroll
        for (int k = 0; k < 8; ++k) {
            __builtin_amdgcn_sched_barrier(0);
            if (k + 4 < 8) E2_LOAD(k + 4);
            __builtin_amdgcn_sched_barrier(0);
            const int ai = k >> 2, m = k & 3; const int row = row0 + ai * 128 + m * 16;
            u16* xr = X16 + (size_t)row * D + col0;
            float ss = 0.f;
#pragma unroll
            for (int bj = 0; bj < 2; ++bj) {
                const f16x8 h = __builtin_bit_cast(f16x8, xv[k % 5][bj]);
                f32x4 x0, x1;
#pragma unroll
                for (int e = 0; e < 4; ++e) { x0[e] = (float)h[e]; x1[e] = (float)h[4 + e]; }
                x0 = x0 + gv[bj][0] * acc[ai][bj][m][0]; x1 = x1 + gv[bj][1] * acc[ai][bj][m][1];
                ss += (x0[0] * x0[0] + x0[1] * x0[1]) + (x0[2] * x0[2] + x0[3] * x0[3]) + (x1[0] * x1[0] + x1[1] * x1[1]) + (x1[2] * x1[2] + x1[3] * x1[3]);
                u32x4 w; w.x = pkh(x0[0], x0[1]); w.y = pkh(x0[2], x0[3]); w.z = pkh(x1[0], x1[1]); w.w = pkh(x1[2], x1[3]);
                *(u32x4*)(xr + bj * 128) = w;
            }
            ss += __shfl_xor(ss, 16); ss += __shfl_xor(ss, 32);
            if (fq == 0) atomicAdd(ssq + row, ss);
        }
#undef E2_LOAD
    }
};

__device__ __forceinline__ void transpose_item(const float* src, int pitch, int ncols, int K, bf16_t* dst, LAS float* scr, int item, int lane) {
    const int nblk = ncols / 32, kb = item / nblk, nb = item % nblk, k0 = 64 * kb, n0 = 32 * nb;
    f32x4 ld[8];
#pragma unroll
    for (int i = 0; i < 8; ++i) { const int kk = 8 * i + (lane >> 3); ld[i] = *(const f32x4*)(src + (size_t)(k0 + kk) * pitch + n0 + 4 * (lane & 7)); }
#pragma unroll
    for (int i = 0; i < 8; ++i) { const int kk = 8 * i + (lane >> 3); LAS float* d = scr + kk * 33 + 4 * (lane & 7); d[0] = ld[i][0]; d[1] = ld[i][1]; d[2] = ld[i][2]; d[3] = ld[i][3]; }
    asm volatile("s_waitcnt lgkmcnt(0)" ::: "memory");
    const int c = lane & 7;
#pragma unroll
    for (int j = 0; j < 4; ++j) { const int n = (lane >> 3) + 8 * j; const LAS float* s = scr + (8 * c) * 33 + n;
        u32x4 o; o.x = cvt_pk_bf16(s[0 * 33], s[1 * 33]); o.y = cvt_pk_bf16(s[2 * 33], s[3 * 33]); o.z = cvt_pk_bf16(s[4 * 33], s[5 * 33]); o.w = cvt_pk_bf16(s[6 * 33], s[7 * 33]);
        *(u32x4*)(dst + (size_t)(n0 + n) * K + k0 + 8 * c) = o; }
    asm volatile("s_waitcnt lgkmcnt(0)" ::: "memory");
}

__device__ __forceinline__ void phase_p0a(const Params& p, LAS unsigned char* lds, int bid, int G, int tid, int lane, int wave) {
    asm volatile("" : "+v"(tid), "+v"(lane), "+s"(wave), "+s"(bid), "+s"(G));
    size_t wso = 0; asm volatile("" : "+s"(wso)); unsigned char* ws = p.ws + wso;
    const float* w_in = p.in[7]; const float* w_out = p.in[8];
    bf16_t* WinT = (bf16_t*)(ws + WS_WIN); bf16_t* WoutT = (bf16_t*)(ws + WS_WOUT);
    const int gw = bid * 8 + wave, NGW = G * 8, gtid = bid * NTHR + tid, NT = G * NTHR;
    {
        LAS float* scr = (LAS float*)(lds + wave * 8448);
        for (int it = gw; it < 4608 + 2048; it += NGW) {
            if (it < 4608) {
                const int sub = it & 127, lt = it >> 7, l = lt / 9, ti = lt % 9;
                const int pn = ti < 4 ? ti : (ti < 8 ? ti + 1 : 11);
                const int sc = ti == 0 ? 256 : ti == 1 ? 512 : ti == 2 ? 1536 : ti == 3 ? 1792 : ti == 4 ? 768 : ti == 5 ? 1024 : ti == 6 ? 2048 : ti == 7 ? 2560 : 2304;
                transpose_item(w_in + (size_t)l * D * DIN + sc, DIN, 256, D, WinT + ((size_t)l * NIN + pn * 256) * D, scr, sub, lane);
            } else {
                const int r = it - 4608, l = r >> 9, sub = r & 511;
                transpose_item(w_out + (size_t)l * D * D, D, D, D, WoutT + (size_t)l * D * D, scr, sub, lane);
            }
        }
    }
    __syncthreads();
    {
        const float* pool_w = p.in[9]; const float* pool_scale = p.in[10]; const float* fnet_w = p.in[14];
        LAS float* Mf = (LAS float*)lds; LAS float* Wt = (LAS float*)(lds + 16384); LAS float* cs = (LAS float*)(lds + 33024); LAS u16* Ot = (LAS u16*)(lds + 36864); LAS float* Fw = (LAS float*)(lds + 46080);
        for (int it = bid; it < 768; it += G) {
            const int kb = it & 15, g = (it >> 4) & 3, kind = (it >> 6) % 3, l = it / 192;
            if (tid < 64) { cs[tid] = cospif((float)tid * (1.f / 32.f)); cs[64 + tid] = sinpif((float)tid * (1.f / 32.f)); }
            const float* wsrc = w_in + (size_t)l * D * DIN + (kind == 0 ? 0 : 1280) + g * 64;
#pragma unroll
            for (int i = 0; i < 8; ++i) { const int e = tid + 512 * i, kk = e >> 6, c = e & 63; Wt[kk * 65 + c] = wsrc[(size_t)(kb * 64 + kk) * DIN + c]; }
            if (kind != 0) {
#pragma unroll
                for (int i = 0; i < 8; ++i) { const int e = tid + 512 * i; Fw[e] = fnet_w[(l * 4 + g) * 4096 + e]; } }
            __syncthreads();
#pragma unroll 1
            for (int i = 0; i < 8; ++i) {
                const int e = tid + 512 * i, c = e >> 6, d = e & 63; float v;
                if (kind == 0) v = pool_w[((l * 4 + g) * 64 + c) * 64 + d] * pool_scale[l * 256 + g * 64 + d];
                else { float s = 0.f; const int co = kind == 1 ? 0 : 64;
#pragma unroll 16
                    for (int cp = 0; cp < 64; ++cp) s += cs[co + ((c * cp) & 63)] * Fw[cp * 64 + d];
                    v = s * (kind == 1 ? 0.125f : -0.125f); }
                Mf[c * 64 + d] = v;
            }
            __syncthreads();
#pragma unroll 1
            for (int i = 0; i < 8; ++i) { const int kk = wave + 8 * i; float s = 0.f;
#pragma unroll 16
                for (int c = 0; c < 64; ++c) s += Wt[kk * 65 + c] * Mf[c * 64 + lane];
                Ot[lane * 72 + kk] = (u16)f2bf(s); }
            __syncthreads();
            { const int d = tid >> 3, ch = tid & 7, pn = kind == 0 ? 4 : (kind == 1 ? 9 : 10);
              const u32x4 v = *(const LAS u32x4*)(Ot + d * 72 + ch * 8);
              *(u32x4*)(WinT + ((size_t)l * NIN + pn * 256 + g * 64 + d) * D + kb * 64 + ch * 8) = v; }
            __syncthreads();
        }
    }
    { const f32x4* s4 = (const f32x4*)p.in[12]; u32x2* d2 = (u32x2*)(ws + WS_SGUW);
      for (int e = gtid; e < 65536; e += NT) { const f32x4 v = s4[e]; u32x2 o; o.x = cvt_pk_bf16(v[0], v[1]); o.y = cvt_pk_bf16(v[2], v[3]); d2[e] = o; } }
    {
        const float* cp_ = p.in[2]; const float* cs_ = p.in[3]; const float* w_ada = p.in[5]; const float* b_ada = p.in[6]; float* mod = (float*)(ws + WS_MOD);
        LAS float* sc = (LAS float*)lds; LAS float* red = (LAS float*)(lds + 40960);
        for (int it = bid; it < 192; it += G) {
            const int l = it / 48, jb = it % 48;
            for (int e = tid; e < 10240; e += NTHR) { const int b = e >> 10, k = e & 1023; const float cv = b < 8 ? cp_[b * 1024 + k] : cs_[(b - 8) * 1024 + k]; sc[e] = cv / (1.f + expf(-cv)); }
            __syncthreads();
            float a[10];
#pragma unroll
            for (int b = 0; b < 10; ++b) a[b] = 0.f;
            const float* wp = w_ada + ((size_t)l * 1024 + wave * 128) * 3072 + jb * 64 + lane;
#pragma unroll 16
            for (int kk = 0; kk < 128; ++kk) { const float wv = wp[(size_t)kk * 3072];
#pragma unroll
                for (int b = 0; b < 10; ++b) a[b] += sc[b * 1024 + wave * 128 + kk] * wv; }
#pragma unroll
            for (int b = 0; b < 10; ++b) red[(wave * 10 + b) * 64 + lane] = a[b];
            __syncthreads();
            for (int e = tid; e < 640; e += NTHR) { const int b = e >> 6, j = e & 63; float s = 0.f;
#pragma unroll
                for (int w = 0; w < 8; ++w) s += red[(w * 10 + b) * 64 + j];
                mod[(l * 10 + b) * 3072 + jb * 64 + j] = s + b_ada[l * 3072 + jb * 64 + j]; }
            __syncthreads();
        }
    }
    {
        _Float16* C128 = (_Float16*)(ws + WS_DFT + DF_C128); _Float16* S128 = (_Float16*)(ws + WS_DFT + DF_S128); _Float16* NS128 = (_Float16*)(ws + WS_DFT + DF_NS128);
        _Float16* T1 = (_Float16*)(ws + WS_DFT + DF_T1); _Float16* T2 = (_Float16*)(ws + WS_DFT + DF_T2);
        float* TW16K = (float*)(ws + WS_DFT + DF_TW16K); float* TW2K = (float*)(ws + WS_DFT + DF_TW2K);
        for (int e = gtid; e < 16384; e += NT) {
            const int k = e >> 7, n = e & 127, m = (k * n) & 127;
            const float c = cospif((float)m * (1.f / 64.f)) * 0.08838834764831845f, s = sinpif((float)m * (1.f / 64.f)) * 0.08838834764831845f;
            C128[e] = (_Float16)c; S128[e] = (_Float16)s; NS128[e] = (_Float16)(-s);
            const float ang = (float)(k * n) * (1.f / 8192.f);
            TW16K[2 * e] = cospif(ang); TW16K[2 * e + 1] = -sinpif(ang);
        }
        for (int e = gtid; e < 512; e += NT) {
            const int k1 = e >> 5, kk = e & 31, n1 = kk & 15, m = (k1 * n1) & 15;
            const float c = cospif((float)m * 0.125f) * 0.25f, s = sinpif((float)m * 0.125f) * 0.25f;
            T1[e] = (_Float16)(kk < 16 ? c : s); T2[e] = (_Float16)(kk < 16 ? -s : c);
        }
        for (int e = gtid; e < 2048; e += NT) {
            const int k1 = e >> 7, n2 = e & 127; const float ang = (float)(k1 * n2) * (1.f / 1024.f);
            TW2K[2 * e] = cospif(ang); TW2K[2 * e + 1] = -sinpif(ang);
        }
    }
}

__device__ __forceinline__ void gen_w16(const Params& p, unsigned char* ws, int l, int gtid, int NT) {
    const bf16_t* Wm = (const bf16_t*)(ws + WS_WIN) + (size_t)l * NIN * D; u16* W16 = (u16*)(ws + WS_W16);
    const float* sc = (const float*)(ws + WS_MOD) + (size_t)l * NB * 3072 + 1024; const float* ng = p.in[4] + l * D;
    const int k8 = (gtid & 127) * 8;
    f32x4 m0[NB], m1[NB];
    { const f32x4 g0 = *(const f32x4*)(ng + k8), g1 = *(const f32x4*)(ng + k8 + 4);
#pragma unroll
      for (int b = 0; b < NB; ++b) { m0[b] = g0 * (1.f + *(const f32x4*)(sc + b * 3072 + k8)); m1[b] = g1 * (1.f + *(const f32x4*)(sc + b * 3072 + k8 + 4)); } }
    for (int idx = gtid; idx < NIN * 128; idx += 2 * NT) {
        const int n0 = idx >> 7, n1 = (idx + NT) >> 7; const bool has1 = idx + NT < NIN * 128;
        const u32x4 wr0 = *(const u32x4*)(Wm + (size_t)n0 * D + k8);
        u32x4 wr1 = (u32x4){0u, 0u, 0u, 0u}; if (has1) wr1 = *(const u32x4*)(Wm + (size_t)n1 * D + k8);
        __builtin_amdgcn_sched_barrier(0);
        float w[8]; unpack8(wr0, w);
#pragma unroll
        for (int b = 0; b < NB; ++b) {
            u32x4 o; o.x = pkh(w[0] * m0[b][0], w[1] * m0[b][1]); o.y = pkh(w[2] * m0[b][2], w[3] * m0[b][3]); o.z = pkh(w[4] * m1[b][0], w[5] * m1[b][1]); o.w = pkh(w[6] * m1[b][2], w[7] * m1[b][3]);
            *(u32x4*)(W16 + ((size_t)b * NIN + n0) * D + k8) = o;
        }
        if (has1) { unpack8(wr1, w);
#pragma unroll
            for (int b = 0; b < NB; ++b) {
                u32x4 o; o.x = pkh(w[0] * m0[b][0], w[1] * m0[b][1]); o.y = pkh(w[2] * m0[b][2], w[3] * m0[b][3]); o.z = pkh(w[4] * m1[b][0], w[5] * m1[b][1]); o.w = pkh(w[6] * m1[b][2], w[7] * m1[b][3]);
                *(u32x4*)(W16 + ((size_t)b * NIN + n1) * D + k8) = o;
            } }
    }
}

__device__ __forceinline__ void phase_p0b(const Params& p, LAS unsigned char* lds, int bid, int G, int tid, int lane, int wave) {
    asm volatile("" : "+v"(tid), "+v"(lane), "+s"(wave), "+s"(bid), "+s"(G));
    size_t wso = 0; asm volatile("" : "+s"(wso)); unsigned char* ws = p.ws + wso;
    const float* mod = (const float*)(ws + WS_MOD); const float* norm_g = p.in[4];
    const int gw = bid * 8 + wave, NGW = G * 8, gtid = bid * NTHR + tid, NT = G * NTHR;
    {
        const bf16_t* WinT = (const bf16_t*)(ws + WS_WIN); float* sb = (float*)(ws + WS_SB);
        const int fr = lane & 15, quad = lane >> 4;
        for (int it = gw; it < NLAYER * (NIN / 16); it += NGW) {
            const int l = it / (NIN / 16), n0 = (it % (NIN / 16)) * 16;
            const bf16_t* wrow = WinT + ((size_t)l * NIN + n0 + fr) * D + quad * 8;
            const float* srow = mod + (size_t)(l * NB + (fr < NB ? fr : 0)) * 3072 + quad * 8;
            f32x4 acc0 = (f32x4){0.f, 0.f, 0.f, 0.f}, acc1 = acc0;
#pragma unroll 1
            for (int kh = 0; kh < 2; ++kh) {
                bf16x8 bw[16]; f32x4 sa[16][2];
#pragma unroll
                for (int ks = 0; ks < 16; ++ks) { const int k0 = (kh * 16 + ks) * 32; bw[ks] = *(const bf16x8*)(wrow + k0); sa[ks][0] = *(const f32x4*)(srow + k0); sa[ks][1] = *(const f32x4*)(srow + k0 + 4); }
                __builtin_amdgcn_sched_barrier(0);
#pragma unroll
                for (int ks = 0; ks < 16; ++ks) {
                    u32x4 aw; aw.x = cvt_pk_bf16(sa[ks][0][0], sa[ks][0][1]); aw.y = cvt_pk_bf16(sa[ks][0][2], sa[ks][0][3]); aw.z = cvt_pk_bf16(sa[ks][1][0], sa[ks][1][1]); aw.w = cvt_pk_bf16(sa[ks][1][2], sa[ks][1][3]);
                    if (fr >= NB) aw = (u32x4){0u, 0u, 0u, 0u};
                    if (ks & 1) acc1 = mma_bf16(__builtin_bit_cast(bf16x8, aw), bw[ks], acc1); else acc0 = mma_bf16(__builtin_bit_cast(bf16x8, aw), bw[ks], acc0);
                }
            }
#pragma unroll
            for (int j = 0; j < 4; ++j) { const int b = quad * 4 + j; if (b < NB) sb[(size_t)(l * NB + b) * NIN + n0 + fr] = acc0[j] + acc1[j]; }
        }
    }
    {
        u16* X16 = (u16*)(ws + WS_X16); float* ssq = (float*)(ws + WS_SSQ);
        for (int row0 = gw * 8; row0 < MTOK; row0 += NGW * 8) {
            const float* xr = row0 < NPT ? p.in[0] + (size_t)row0 * D : p.in[1] + (size_t)(row0 - NPT) * D;
            f32x4 v[8][4];
#pragma unroll
            for (int r = 0; r < 8; ++r)
#pragma unroll
                for (int j = 0; j < 4; ++j) v[r][j] = *(const f32x4*)(xr + (size_t)r * D + 4 * (lane + 64 * j));
            __builtin_amdgcn_sched_barrier(0);
#pragma unroll
            for (int r = 0; r < 8; ++r) {
                float ss = 0.f;
#pragma unroll
                for (int j = 0; j < 4; ++j) {
                    const f32x4 x = v[r][j];
                    ss += (x[0] * x[0] + x[1] * x[1]) + (x[2] * x[2] + x[3] * x[3]);
                    u32x2 o; o.x = pkh(x[0], x[1]); o.y = pkh(x[2], x[3]);
                    *(u32x2*)(X16 + (size_t)(row0 + r) * D + 4 * (lane + 64 * j)) = o;
                }
                ss = wave_sum(ss);
                if (lane == 0) ssq[row0 + r] = ss;
            }
        }
    }
    gen_w16(p, ws, 0, gtid, NT);
}

__device__ __forceinline__ void phase_final(const Params& p, int bid, int G, int lane, int wave) {
    const float* ssq = (const float*)(p.ws + WS_SSQ); const float* fg = p.in[16]; const u16* X16 = (const u16*)(p.ws + WS_X16);
    const int gw = bid * 8 + wave, NGW = G * 8;
    for (int row0 = gw * 8; row0 < MTOK; row0 += NGW * 8) {
        u32x4 xh[8][2]; float sq[8];
#pragma unroll
        for (int r = 0; r < 8; ++r) { sq[r] = ssq[row0 + r]; xh[r][0] = *(const u32x4*)(X16 + (size_t)(row0 + r) * D + lane * 8); xh[r][1] = *(const u32x4*)(X16 + (size_t)(row0 + r) * D + 512 + lane * 8); }
        f32x4 g[2][2];
#pragma unroll
        for (int hh = 0; hh < 2; ++hh) { g[hh][0] = *(const f32x4*)(fg + hh * 512 + lane * 8); g[hh][1] = *(const f32x4*)(fg + hh * 512 + lane * 8 + 4); }
        __builtin_amdgcn_sched_barrier(0);
#pragma unroll
        for (int r = 0; r < 8; ++r) { const float rs = __builtin_amdgcn_rsqf(sq[r] * (1.f / 1024.f) + RMS_EPS);
            float* orow = p.out + (size_t)(row0 + r) * D + lane * 8;
#pragma unroll
            for (int hh = 0; hh < 2; ++hh) { const f16x8 h = __builtin_bit_cast(f16x8, xh[r][hh]);
                f32x4 a, c;
#pragma unroll
                for (int e = 0; e < 4; ++e) { a[e] = (float)h[e] * rs; c[e] = (float)h[4 + e] * rs; }
                *(f32x4*)(orow + hh * 512) = a * g[hh][0]; *(f32x4*)(orow + hh * 512 + 4) = c * g[hh][1]; } }
    }
}

constexpr int FP = 272;
constexpr int F_UP = 0, F_UQ = 34816, F_APR = 69632, F_API = 104448, F_YST = 0;

__device__ __forceinline__ void phase_p2a(const Params& p, LAS unsigned char* lds, int bid, int G, int tid, int lane, int wave, const int mode = 3) {
    asm volatile("" : "+v"(tid), "+v"(lane), "+s"(wave), "+s"(bid), "+s"(G));
    size_t wso = 0; asm volatile("" : "+s"(wso)); unsigned char* ws = p.ws + wso;
    const int gtid = bid * NTHR + tid, NT = G * NTHR, fr = lane & 15, quad = lane >> 4;
    { float* ssq = (float*)(ws + WS_SSQ); for (int e = gtid; e < MTOK; e += NT) ssq[e] = 0.f; }
    const u16* ZT = (const u16*)(ws + WS_ZT); u16* YT = (u16*)(ws + WS_ZT);
    const bf16x8* C128 = (const bf16x8*)(ws + WS_DFT + DF_C128); const bf16x8* S128 = (const bf16x8*)(ws + WS_DFT + DF_S128); const bf16x8* NS128 = (const bf16x8*)(ws + WS_DFT + DF_NS128);
    const bf16x8* T1 = (const bf16x8*)(ws + WS_DFT + DF_T1); const bf16x8* T2 = (const bf16x8*)(ws + WS_DFT + DF_T2);
    const f32x2* TW16K = (const f32x2*)(ws + WS_DFT + DF_TW16K); const f32x2* TW2K = (const f32x2*)(ws + WS_DFT + DF_TW2K);
    u32x4 stU[8];
#define FFT_ISSUE(uu) do { const bool big_ = (uu) < 512; int bs_, ch0_; \
        if (big_) { bs_ = NPT + ((uu) >> 8) * 16384; ch0_ = (uu) & 255; } else { const int v_ = (uu) - 512; bs_ = (v_ >> 5) * 2048; ch0_ = (v_ & 31) * 8; } \
        _Pragma("unroll") for (int i = 0; i < 8; ++i) { const int c = tid + 512 * i, mat = c >> 11, cc = c & 2047, r = cc >> 4, k16 = cc & 15; \
            const int chan = big_ ? ch0_ : ch0_ + (r >> 4), roff = big_ ? r * 128 : (r & 15) * 128; \
            stU[i] = *(const u32x4*)(ZT + (size_t)(mat * 256 + chan) * MTOK + bs_ + roff + k16 * 8); } } while (0)
    if ((mode & 1) && bid < 768) FFT_ISSUE(bid);
    bf16x8 cf[4], sf[4], nsf[4];
#pragma unroll
    for (int ks = 0; ks < 4; ++ks) { const int off = ((wave * 16 + fr) * 128 + ks * 32 + quad * 8) >> 3; cf[ks] = C128[off]; sf[ks] = S128[off]; nsf[ks] = NS128[off]; }
    if (mode & 1)
    for (int u = bid; u < 768; u += G) {
        const bool big = u < 512;
        int bs, ch0;
        if (big) { bs = NPT + (u >> 8) * 16384; ch0 = u & 255; } else { const int v = u - 512; bs = (v >> 5) * 2048; ch0 = (v & 31) * 8; }
#pragma unroll
        for (int i = 0; i < 8; ++i) { const int c = tid + 512 * i, mat = c >> 11, cc = c & 2047, r = cc >> 4, k16 = cc & 15; *(LAS u32x4*)(lds + mat * 34816 + r * FP + k16 * 16) = stU[i]; }
        f32x2 twn[4];
#pragma unroll
        for (int j = 0; j < 4; ++j) twn[j] = big ? TW16K[(wave * 16 + quad * 4 + j) * 128 + fr] : TW2K[(quad * 4 + j) * 128 + fr];
        __syncthreads();
        { const int un = (u + G < 768) ? u + G : u; FFT_ISSUE(un); }
        __builtin_amdgcn_sched_barrier(0);
        if (big) {
            const int mt = wave;
#pragma unroll 2
            for (int nt = 0; nt < 8; ++nt) {
                f32x2 twc[4];
#pragma unroll
                for (int j = 0; j < 4; ++j) { twc[j] = twn[j]; twn[j] = TW16K[(mt * 16 + quad * 4 + j) * 128 + min(nt + 1, 7) * 16 + fr]; }
                bf16x8 bu[4], bi[4];
#pragma unroll
                for (int ks = 0; ks < 4; ++ks) { bu[ks] = tr_frag(lds + F_UP, FP, ks * 32 + quad * 8, nt * 16, lane); bi[ks] = tr_frag(lds + F_UQ, FP, ks * 32 + quad * 8, nt * 16, lane); }
                f32x4 ar = (f32x4){0.f, 0.f, 0.f, 0.f}, ai = (f32x4){0.f, 0.f, 0.f, 0.f};
#pragma unroll
                for (int ks = 0; ks < 4; ++ks) { ar = mma_f16(cf[ks], bu[ks], ar); ar = mma_f16(sf[ks], bi[ks], ar); ai = mma_f16(cf[ks], bi[ks], ai); ai = mma_f16(nsf[ks], bu[ks], ai); }
                const int n2 = nt * 16 + fr;
                f16x4 pr, pi;
#pragma unroll
                for (int j = 0; j < 4; ++j) { const f32x2 t2_ = twc[j];
                    pr[j] = (_Float16)(ar[j] * t2_.x - ai[j] * t2_.y); pi[j] = (_Float16)(ar[j] * t2_.y + ai[j] * t2_.x); }
                *(LAS f16x4*)(lds + F_APR + n2 * FP + (mt * 16 + quad * 4) * 2) = pr;
                *(LAS f16x4*)(lds + F_API + n2 * FP + (mt * 16 + quad * 4) * 2) = pi;
            }
        } else {
            const bf16x8 t1 = T1[(fr * 32 + quad * 8) >> 3], t2 = T2[(fr * 32 + quad * 8) >> 3];
#pragma unroll 2
            for (int nt = 0; nt < 8; ++nt) {
                const bf16x8 bf = tr_frag(lds + (quad < 2 ? F_UP : F_UQ), FP, wave * 16 + (quad & 1) * 8, nt * 16, lane);
                f32x2 twc[4];
#pragma unroll
                for (int j = 0; j < 4; ++j) { twc[j] = twn[j]; twn[j] = TW2K[(quad * 4 + j) * 128 + min(nt + 1, 7) * 16 + fr]; }
                const f32x4 z4 = (f32x4){0.f, 0.f, 0.f, 0.f};
                const f32x4 ar = mma_f16(t1, bf, z4), ai = mma_f16(t2, bf, z4);
                const int n2 = nt * 16 + fr;
                f16x4 pr, pi;
#pragma unroll
                for (int j = 0; j < 4; ++j) { const f32x2 tw = twc[j];
                    pr[j] = (_Float16)(ar[j] * tw.x - ai[j] * tw.y); pi[j] = (_Float16)(ar[j] * tw.y + ai[j] * tw.x); }
                *(LAS f16x4*)(lds + F_APR + n2 * FP + (wave * 16 + quad * 4) * 2) = pr;
                *(LAS f16x4*)(lds + F_API + n2 * FP + (wave * 16 + quad * 4) * 2) = pi;
            }
        }
        __syncthreads();
        {
            const int mt = wave;
#pragma unroll 2
            for (int nt = 0; nt < 8; ++nt) {
                bf16x8 br[4], bq[4];
#pragma unroll
                for (int ks = 0; ks < 4; ++ks) { br[ks] = tr_frag(lds + F_APR, FP, ks * 32 + quad * 8, nt * 16, lane); bq[ks] = tr_frag(lds + F_API, FP, ks * 32 + quad * 8, nt * 16, lane); }
                f32x4 y = (f32x4){0.f, 0.f, 0.f, 0.f};
#pragma unroll
                for (int ks = 0; ks < 4; ++ks) { y = mma_f16(cf[ks], br[ks], y); y = mma_f16(sf[ks], bq[ks], y); }
                const int col = nt * 16 + fr;
#pragma unroll
                for (int j = 0; j < 4; ++j) { const int k2 = mt * 16 + quad * 4 + j; *(LAS _Float16*)(lds + F_YST + (k2 * 128 + col) * 2) = (_Float16)y[j]; }
            }
        }
        __syncthreads();
#pragma unroll
        for (int i = 0; i < 4; ++i) {
            const int c = tid + 512 * i;
            if (big) { const u32x4 v = *(const LAS u32x4*)(lds + F_YST + c * 16); *(u32x4*)(YT + (size_t)ch0 * MTOK + bs + c * 8) = v; }
            else { const int chl = c >> 8, k2 = (c & 255) >> 1, h8 = c & 1;
                const u32x4 v = *(const LAS u32x4*)(lds + F_YST + (k2 * 128 + chl * 16 + h8 * 8) * 2);
                *(u32x4*)(YT + (size_t)(ch0 + chl) * MTOK + bs + k2 * 16 + h8 * 8) = v; }
        }
        __syncthreads();
    }
    if (mode & 2) {
        bf16_t* Z = (bf16_t*)(ws + WS_Z);
        for (int idx = gtid; idx < (MTOK / 4) * 32; idx += NT) {
            const int t0 = (idx >> 5) * 4, cg8 = idx & 31, g = cg8 >> 3, half = 1 << g;
            const int b = batch_of_tok(t0), bs = b < 8 ? b * 2048 : NPT + (b - 8) * 16384, be = bs + (b < 8 ? 2048 : 16384);
            const bf16_t* ap = Z + 1024 + cg8 * 8;
            u32x4 rw[19], gt4[4];
#pragma unroll
            for (int i = 0; i < 19; ++i) { const int off = i - 8, tt = t0 + off; rw[i] = (u32x4){0u, 0u, 0u, 0u}; if (off >= -half && off < 3 + half && tt >= bs && tt < be) rw[i] = *(const u32x4*)(ap + (size_t)tt * ZW); }
#pragma unroll
            for (int k = 0; k < 4; ++k) gt4[k] = *(const u32x4*)(Z + (size_t)(t0 + k) * ZW + cg8 * 8);
            __builtin_amdgcn_sched_barrier(0);
            float s[4][8];
#pragma unroll
            for (int k = 0; k < 4; ++k)
#pragma unroll
                for (int e = 0; e < 8; ++e) s[k][e] = 0.f;
#pragma unroll
            for (int i = 0; i < 19; ++i) { float f[8]; unpack8(rw[i], f); const int off = i - 8;
#pragma unroll
                for (int k = 0; k < 4; ++k) { const bool in = (off >= k - half) && (off < k + half);
#pragma unroll
                    for (int e = 0; e < 8; ++e) s[k][e] += in ? f[e] : 0.f; } }
#pragma unroll
            for (int k = 0; k < 4; ++k) {
                const int t = t0 + k, lo = max(t - half, bs), hi = min(t + half, be);
                const float inv = 1.f / (float)(hi - lo);
                float a[8], gt[8]; unpack8(rw[8 + k], a); unpack8(gt4[k], gt);
                float o[8];
#pragma unroll
                for (int e = 0; e < 8; ++e) o[e] = (s[k][e] * inv - a[e]) * gt[e];
                u32x4 w; w.x = cvt_pk_bf16(o[0], o[1]); w.y = cvt_pk_bf16(o[2], o[3]); w.z = cvt_pk_bf16(o[4], o[5]); w.w = cvt_pk_bf16(o[6], o[7]);
                bf16_t* op = (mode & 4) ? (bf16_t*)(ws + WS_END) + (size_t)t * 256 + cg8 * 8 : Z + (size_t)t * ZW + cg8 * 8;
                *(u32x4*)op = w;
            }
        }
    }
}

constexpr int VP = 528;
constexpr int SGS_OFF = 69632;
constexpr int NAK_OFF = 0, NAKP = 144, NAV_OFF = 73728, NAVP = 1040;
constexpr int RPB_OFF = 140288;
constexpr int NAEX_OFF = 147728;

__device__ __forceinline__ void phase_p2b(const Params& p, LAS unsigned char* lds, int l, int bid, int G, int tid, int lane, int wave, const int mode = 7) {
    asm volatile("" : "+v"(tid), "+v"(lane), "+s"(wave), "+s"(bid), "+s"(G));
    size_t wso = 0; asm volatile("" : "+s"(wso)); unsigned char* ws = p.ws + wso;
    bf16_t* Z = (bf16_t*)(ws + WS_Z);
    const int fr = lane & 15, quad = lane >> 4;
    { LAS float* rp = (LAS float*)(lds + RPB_OFF); const float* src = p.in[15] + l * 1860; for (int e = tid; e < 1860; e += NTHR) rp[e] = src[e] * 1.44269504089f; }
    __syncthreads();
    bf16_t* DUM = (bf16_t*)(ws + WS_END);
    if (mode & 1) {
        const float* ng = p.in[11] + l * 256; const float* sgb = p.in[13] + l * 512; const bf16_t* SW = (const bf16_t*)(ws + WS_SGUW) + (size_t)l * 4 * 128 * 128;
        const int vcu_s = (G % 8 == 0) ? (bid % 8) * (G / 8) + bid / 8 : bid;
        for (int it = vcu_s; it < 384; it += G) {
            const int t0 = it * 128;
            {
                const int slot = tid >> 5, ck = tid & 31;
                u32x4 vraw[8];
#pragma unroll
                for (int i = 0; i < 8; ++i) vraw[i] = *(const u32x4*)(Z + (size_t)(t0 + i * 16 + slot) * ZW + 1280 + ck * 8);
                const f32x4 g0 = *(const f32x4*)(ng + ck * 8), g1 = *(const f32x4*)(ng + ck * 8 + 4);
                __builtin_amdgcn_sched_barrier(0);
#pragma unroll
                for (int i = 0; i < 8; ++i) {
                    float v[8]; unpack8(vraw[i], v);
                    float s1 = 0.f, s2 = 0.f;
#pragma unroll
                    for (int e = 0; e < 8; ++e) { s1 += v[e]; s2 += v[e] * v[e]; }
#pragma unroll
                    for (int o = 1; o < 32; o <<= 1) { s1 += __shfl_xor(s1, o); s2 += __shfl_xor(s2, o); }
                    const float mean = s1 * (1.f / 256.f), rstd = __builtin_amdgcn_rsqf(fmaxf(s2 * (1.f / 256.f) - mean * mean, 0.f) + LN_EPS);
                    u32x4 w; w.x = cvt_pk_bf16((v[0] - mean) * rstd * g0[0], (v[1] - mean) * rstd * g0[1]); w.y = cvt_pk_bf16((v[2] - mean) * rstd * g0[2], (v[3] - mean) * rstd * g0[3]);
                    w.z = cvt_pk_bf16((v[4] - mean) * rstd * g1[0], (v[5] - mean) * rstd * g1[1]); w.w = cvt_pk_bf16((v[6] - mean) * rstd * g1[2], (v[7] - mean) * rstd * g1[3]);
                    *(LAS u32x4*)(lds + (i * 16 + slot) * VP + ck * 16) = w;
                }
            }
            u32x4 uu[8];
            { const int slot = tid >> 5, ck = tid & 31;
#pragma unroll
              for (int i = 0; i < 8; ++i) uu[i] = *(const u32x4*)(Z + (size_t)(t0 + i * 16 + slot) * ZW + 256 + ck * 8); }
            {
                const int h = wave >> 1, ph = wave & 1;
                bf16x8 bw[4][4]; float bias[4];
#pragma unroll
                for (int nt = 0; nt < 4; ++nt) {
                    const int prow = ph * 64 + nt * 16 + fr;
#pragma unroll
                    for (int ks = 0; ks < 4; ++ks) bw[nt][ks] = *(const bf16x8*)(SW + ((size_t)h * 128 + prow) * 128 + ks * 32 + quad * 8);
                    bias[nt] = sgb[h * 128 + prow];
                }
                __builtin_amdgcn_sched_barrier(0);
                __syncthreads();
                bf16x8 a[4][4];
#pragma unroll
                for (int mt = 0; mt < 4; ++mt)
#pragma unroll
                    for (int ks = 0; ks < 4; ++ks) a[mt][ks] = tr_frag(lds, VP, ks * 32 + quad * 8, h * 64 + mt * 16, lane);
#pragma unroll
                for (int nt = 0; nt < 4; ++nt) {
                    f32x4 acc[4];
#pragma unroll
                    for (int mt = 0; mt < 4; ++mt) acc[mt] = (f32x4){0.f, 0.f, 0.f, 0.f};
                    const int prow = ph * 64 + nt * 16 + fr;
#pragma unroll
                    for (int ks = 0; ks < 4; ++ks)
#pragma unroll
                        for (int mt = 0; mt < 4; ++mt) acc[mt] = mma_bf16(a[mt][ks], bw[nt][ks], acc[mt]);
#pragma unroll
                    for (int mt = 0; mt < 4; ++mt) {
                        const int c = h * 64 + mt * 16 + quad * 4; const float bb = bias[nt];
                        u32x2 w; w.x = pkh(acc[mt][0] + bb, acc[mt][1] + bb); w.y = pkh(acc[mt][2] + bb, acc[mt][3] + bb);
                        *(LAS u32x2*)(lds + SGS_OFF + prow * VP + c * 2) = w;
                    }
                }
            }
            __syncthreads();
            {
                const int slot = tid >> 5, ck = tid & 31;
                u32x4 gg[8];
#pragma unroll
                for (int i = 0; i < 8; ++i) gg[i] = *(const u32x4*)(Z + (size_t)(t0 + i * 16 + slot) * ZW + 1536 + ck * 8);
                __builtin_amdgcn_sched_barrier(0);
#pragma unroll
                for (int i = 0; i < 8; ++i) {
                    const int prow = i * 16 + slot;
                    const f16x8 sv = __builtin_bit_cast(f16x8, *(const LAS u32x4*)(lds + SGS_OFF + prow * VP + ck * 16));
                    float uf[8], gf[8]; unpack8(uu[i], uf); unpack8(gg[i], gf);
                    u32x4 w; w.x = cvt_pk_bf16(uf[0] * (float)sv[0] * gf[0], uf[1] * (float)sv[1] * gf[1]); w.y = cvt_pk_bf16(uf[2] * (float)sv[2] * gf[2], uf[3] * (float)sv[3] * gf[3]);
                    w.z = cvt_pk_bf16(uf[4] * (float)sv[4] * gf[4], uf[5] * (float)sv[5] * gf[5]); w.w = cvt_pk_bf16(uf[6] * (float)sv[6] * gf[6], uf[7] * (float)sv[7] * gf[7]);
                    if (mode & 8) *(u32x4*)(DUM + (size_t)(t0 + prow) * 256 + ck * 8) = w; else *(u32x4*)(Z + (size_t)(t0 + prow) * ZW + 256 + ck * 8) = w;
                }
            }
            __syncthreads();
        }
    }
    if (mode & 2) {
        const u16* ZT = (const u16*)(ws + WS_ZT);
        const LAS float* rpb = (const LAS float*)(lds + RPB_OFF);
        const int vcu = (G % 8 == 0) ? (bid % 8) * (G / 8) + bid / 8 : bid;
        int jbeg, jend;
        if (G == 256) { jbeg = vcu * 12; jend = jbeg + 12; }
        else { const int per = (3072 + G - 1) / G; jbeg = min(3072, vcu * per); jend = min(3072, jbeg + per); }
        const int cb = wave & 3, half = wave >> 2, c0 = cb == 0 ? 0 : (cb == 1 ? 8 : (cb == 2 ? 24 : 32)), qc = cb * 16 + fr, cst = min(max(qc - 8, 0), 48);
        u32x4 stK0 = (u32x4){0u, 0u, 0u, 0u}, stV0 = stK0; bf16x8 qn[2]; u32x2 ggn[4] = {(u32x2){0u, 0u}, (u32x2){0u, 0u}, (u32x2){0u, 0u}, (u32x2){0u, 0u}};
#define NA_DECODE(j, h_, r_, bs_, rs_) const int h_ = ((j) / 12) & 3; int r_, bs_, rs_; { const int R_ = ((j) / 48) * 12 + (j) % 12; int rows_; \
        if (R_ < 256) { r_ = R_ & 31; rows_ = 32; bs_ = (R_ >> 5) * 2048; } else { const int R2_ = R_ - 256; r_ = R2_ & 255; rows_ = 256; bs_ = NPT + (R2_ >> 8) * 16384; } \
        rs_ = min(max(r_ - 4, 0), rows_ - 8); }
        int pbs = -1, prs = 0, ph = -1, nkind = 2;
        float bvs[4][8]; int pbk = -1;
#pragma unroll
        for (int a_ = 0; a_ < 4; ++a_)
#pragma unroll
            for (int b_ = 0; b_ < 8; ++b_) bvs[a_][b_] = 0.f;
#define NA_KIND(h_, bs_, rs_) (((bs_) == pbs && (h_) == ph) ? ((rs_) == prs ? 0 : ((rs_) == prs + 1 ? 1 : 2)) : 2)
#define NA_ISSUE(kind_, h_, r_, bs_, rs_) do { \
        if ((kind_) == 1) { const int tb_ = bs_ + (rs_ + 7) * 64; \
            stK0 = *(const u32x4*)(Z + (size_t)(tb_ + (tid >> 3)) * ZW + 1792 + h_ * 64 + (tid & 7) * 8); \
            stV0 = *(const u32x4*)(ZT + (size_t)(512 + h_ * 64 + (tid >> 3)) * MTOK + tb_ + (tid & 7) * 8); } \
        const bf16_t* zq_ = Z + (size_t)(bs_ + r_ * 64 + qc) * ZW; \
        _Pragma("unroll") for (int ks = 0; ks < 2; ++ks) qn[ks] = *(const bf16x8*)(zq_ + 768 + h_ * 64 + ks * 32 + quad * 8); \
        if (half == 0) { _Pragma("unroll") for (int mt = 0; mt < 4; ++mt) ggn[mt] = *(const u32x2*)(zq_ + 2048 + h_ * 64 + mt * 16 + quad * 4); }     \
        pbs = bs_; prs = rs_; ph = h_; } while (0)
        if (jbeg < jend) { NA_DECODE(jbeg, h0, r0, bs0, rs0); NA_ISSUE(2, h0, r0, bs0, rs0); }
#pragma unroll 1
        for (int j = jbeg; j < jend; ++j) {
            NA_DECODE(j, h, r, bs, rs);
            const int kind = nkind;
            if (kind == 2) {
                const int tb = bs + rs * 64; u32x4 fk[8], fv[8];
#pragma unroll
                for (int i = 0; i < 8; ++i) { const int idx = tid + 512 * i;
                    fk[i] = *(const u32x4*)(Z + (size_t)(tb + (idx >> 3)) * ZW + 1792 + h * 64 + (idx & 7) * 8);
                    fv[i] = *(const u32x4*)(ZT + (size_t)(512 + h * 64 + (idx >> 6)) * MTOK + tb + (idx & 63) * 8); }
#pragma unroll
                for (int i = 0; i < 8; ++i) { const int idx = tid + 512 * i;
                    *(LAS u32x4*)(lds + NAK_OFF + ((((rs + (idx >> 9)) & 7) * 64) + ((idx >> 3) & 63)) * NAKP + (idx & 7) * 16) = fk[i];
                    *(LAS u32x4*)(lds + NAV_OFF + (idx >> 6) * NAVP + ((((rs + ((idx & 63) >> 3)) & 7) * 64) + (idx & 7) * 8) * 2) = fv[i]; }
            } else if (kind == 1) {
                const int sl = (rs + 7) & 7;
                *(LAS u32x4*)(lds + NAK_OFF + (sl * 64 + (tid >> 3)) * NAKP + (tid & 7) * 16) = stK0;
                *(LAS u32x4*)(lds + NAV_OFF + (tid >> 3) * NAVP + (sl * 64 + (tid & 7) * 8) * 2) = stV0;
            }
            bf16x8 qf[2]; u32x2 gg[4];
#pragma unroll
            for (int ks = 0; ks < 2; ++ks) qf[ks] = qn[ks];
#pragma unroll
            for (int mt = 0; mt < 4; ++mt) gg[mt] = ggn[mt];
            __syncthreads();
            { const int jn = min(j + 1, jend - 1); NA_DECODE(jn, hn, rn, bsn, rsn); nkind = NA_KIND(hn, bsn, rsn); NA_ISSUE(nkind, hn, rn, bsn, rsn); }
            __builtin_amdgcn_sched_barrier(0);
            f32x4 s[8];
            {
                bf16x8 kfr[8][2];
#pragma unroll
                for (int w4 = 0; w4 < 4; ++w4)
#pragma unroll
                    for (int hf = 0; hf < 2; ++hf) {
                        const int key = ((rs + half * 4 + w4) & 7) * 64 + c0 + 8 * (fr >> 2) + (fr & 3) + 4 * hf;
                        const LAS unsigned char* ka = lds + NAK_OFF + key * NAKP + quad * 16;
                        kfr[w4 * 2 + hf][0] = *(const LAS bf16x8*)ka; kfr[w4 * 2 + hf][1] = *(const LAS bf16x8*)(ka + 64);
                    }
                __builtin_amdgcn_sched_barrier(0);
#pragma unroll
                for (int nt = 0; nt < 8; ++nt) { const f32x4 t = mma_bf16(kfr[nt][0], qf[0], (f32x4){0.f, 0.f, 0.f, 0.f}); s[nt] = mma_bf16(kfr[nt][1], qf[1], t); }
            }
            { const int bk = h * 64 + (rs - r + 16);
              if (bk != pbk) { pbk = bk;
                const LAS float* rp = rpb + h * 465;
#pragma unroll
                for (int w4 = 0; w4 < 4; ++w4) {
                    const int dr = rs + half * 4 + w4 - r + 7;
#pragma unroll
                    for (int hf = 0; hf < 2; ++hf)
#pragma unroll
                        for (int jj = 0; jj < 4; ++jj) {
                            const int kc = c0 + 8 * quad + 4 * hf + jj;
                            const bool valid = (kc >= cst) && (kc < cst + 16);
                            bvs[w4][hf * 4 + jj] = rp[valid ? dr * 31 + (kc - qc + 15) : 0];
                        }
                    asm volatile("" : "+v"(bvs[w4][0]), "+v"(bvs[w4][1]), "+v"(bvs[w4][2]), "+v"(bvs[w4][3]), "+v"(bvs[w4][4]), "+v"(bvs[w4][5]), "+v"(bvs[w4][6]), "+v"(bvs[w4][7]));
                } } }
            float mx = -INFINITY;
#pragma unroll
            for (int w4 = 0; w4 < 4; ++w4)
#pragma unroll
                for (int hf = 0; hf < 2; ++hf)
#pragma unroll
                    for (int jj = 0; jj < 4; ++jj) {
                        const int kc = c0 + 8 * quad + 4 * hf + jj;
                        const bool valid = (kc >= cst) && (kc < cst + 16);
                        const float v = valid ? s[w4 * 2 + hf][jj] * 0.18033688011f + bvs[w4][hf * 4 + jj] : -INFINITY;
                        s[w4 * 2 + hf][jj] = v; mx = fmaxf(mx, v);
                    }
            mx = quad_max(mx);
            float lsum = 0.f;
#pragma unroll
            for (int nt = 0; nt < 8; ++nt)
#pragma unroll
                for (int jj = 0; jj < 4; ++jj) { const float pe = __builtin_amdgcn_exp2f(s[nt][jj] - mx); s[nt][jj] = pe; lsum += pe; }
            lsum = quad_sum(lsum);
            f32x4 o[4];
#pragma unroll
            for (int mt = 0; mt < 4; ++mt) o[mt] = (f32x4){0.f, 0.f, 0.f, 0.f};
#pragma unroll
            for (int wb = 0; wb < 2; ++wb) {
                bf16x8 vfr[2][4];
#pragma unroll
                for (int wi = 0; wi < 2; ++wi)
#pragma unroll
                    for (int mt = 0; mt < 4; ++mt) vfr[wi][mt] = *(const LAS bf16x8*)(lds + NAV_OFF + (mt * 16 + fr) * NAVP + (((rs + half * 4 + wb * 2 + wi) & 7) * 64 + c0 + 8 * quad) * 2);
                __builtin_amdgcn_sched_barrier(0);
#pragma unroll
                for (int wi = 0; wi < 2; ++wi) { const int w4 = wb * 2 + wi;
                    u32x4 pw; pw.x = cvt_pk_bf16(s[2 * w4][0], s[2 * w4][1]); pw.y = cvt_pk_bf16(s[2 * w4][2], s[2 * w4][3]); pw.z = cvt_pk_bf16(s[2 * w4 + 1][0], s[2 * w4 + 1][1]); pw.w = cvt_pk_bf16(s[2 * w4 + 1][2], s[2 * w4 + 1][3]);
                    const bf16x8 pf = __builtin_bit_cast(bf16x8, pw);
#pragma unroll
                    for (int mt = 0; mt < 4; ++mt) o[mt] = mma_bf16(vfr[wi][mt], pf, o[mt]); }
            }
            LAS unsigned* ex = (LAS unsigned*)(lds + NAEX_OFF) + cb * 640 + lane;
            if (half == 1) {
                ex[0] = __float_as_uint(mx); ex[64] = __float_as_uint(lsum);
#pragma unroll
                for (int mt = 0; mt < 4; ++mt) { ex[(2 + 2 * mt) * 64] = pkh(o[mt][0], o[mt][1]); ex[(3 + 2 * mt) * 64] = pkh(o[mt][2], o[mt][3]); }
            }
            __syncthreads();
            if (half == 0) {
                const float m1 = __uint_as_float(ex[0]), l1 = __uint_as_float(ex[64]);
                const float m = fmaxf(mx, m1), a0 = __builtin_amdgcn_exp2f(mx - m), a1 = __builtin_amdgcn_exp2f(m1 - m);
                const float inv = 1.f / (lsum * a0 + l1 * a1);
                bf16_t* zr = Z + (size_t)(bs + r * 64 + qc) * ZW;
#pragma unroll
                for (int mt = 0; mt < 4; ++mt) {
                    const f16x2 p01 = __builtin_bit_cast(f16x2, ex[(2 + 2 * mt) * 64]), p23 = __builtin_bit_cast(f16x2, ex[(3 + 2 * mt) * 64]);
                    const float y0 = (o[mt][0] * a0 + (float)p01.x * a1) * inv, y1 = (o[mt][1] * a0 + (float)p01.y * a1) * inv;
                    const float y2 = (o[mt][2] * a0 + (float)p23.x * a1) * inv, y3 = (o[mt][3] * a0 + (float)p23.y * a1) * inv;
                    const int dcol = h * 64 + mt * 16 + quad * 4;
                    u32x2 w; w.x = cvt_pk_bf16(y0 * bf2f(gg[mt].x & 0xffffu), y1 * __uint_as_float(gg[mt].x & 0xffff0000u));
                    w.y = cvt_pk_bf16(y2 * bf2f(gg[mt].y & 0xffffu), y3 * __uint_as_float(gg[mt].y & 0xffff0000u));
                    if (mode & 8) *(u32x2*)(DUM + (size_t)(bs + r * 64 + qc) * 256 + dcol) = w; else *(u32x2*)(zr + 768 + dcol) = w;
                }
            }
        }
#undef NA_DECODE
#undef NA_ISSUE
#undef NA_KIND
    }
    __syncthreads();
    if (mode & 4) {
        const u16* YT = (const u16*)(ws + WS_ZT);
        LAS unsigned char* T = lds + wave * 8448;
        const int vcu_t = (G % 8 == 0) ? (bid % 8) * (G / 8) + bid / 8 : bid;
        for (int it = G - 1 - vcu_t; it < 384; it += G) {
            const int tile = it * 8 + wave, tb = tile >> 2, cbk = tile & 3;
            u32x4 yv[8], gv8[8];
#pragma unroll
            for (int i = 0; i < 8; ++i) { const int ch = i * 8 + (lane >> 3), k8 = lane & 7; yv[i] = *(const u32x4*)(YT + (size_t)(cbk * 64 + ch) * MTOK + tb * 64 + k8 * 8); }
#pragma unroll
            for (int i = 0; i < 8; ++i) { const int tok = i * 8 + (lane >> 3), c8 = lane & 7; gv8[i] = *(const u32x4*)(Z + (size_t)(tb * 64 + tok) * ZW + 512 + cbk * 64 + c8 * 8); }
            __builtin_amdgcn_sched_barrier(0);
#pragma unroll
            for (int i = 0; i < 8; ++i) {
                const int ch = i * 8 + (lane >> 3), k8 = lane & 7;
                LAS unsigned* d = (LAS unsigned*)(T + ch * 132 + k8 * 16);
                d[0] = yv[i].x; d[1] = yv[i].y; d[2] = yv[i].z; d[3] = yv[i].w;
            }
            asm volatile("s_waitcnt lgkmcnt(0)" ::: "memory");
#pragma unroll
            for (int i = 0; i < 8; ++i) {
                const int tok = i * 8 + (lane >> 3), c8 = lane & 7;
                bf16_t* gp = Z + (size_t)(tb * 64 + tok) * ZW + 512 + cbk * 64 + c8 * 8;
                float gt[8]; unpack8(gv8[i], gt);
                float y[8];
#pragma unroll
                for (int e = 0; e < 8; ++e) y[e] = (float)*(const LAS _Float16*)(T + (c8 * 8 + e) * 132 + tok * 2) * gt[e];
                u32x4 w; w.x = cvt_pk_bf16(y[0], y[1]); w.y = cvt_pk_bf16(y[2], y[3]); w.z = cvt_pk_bf16(y[4], y[5]); w.w = cvt_pk_bf16(y[6], y[7]);
                if (mode & 8) *(u32x4*)(DUM + (size_t)(tb * 64 + tok) * 256 + cbk * 64 + c8 * 8) = w; else *(u32x4*)gp = w;
            }
            asm volatile("s_waitcnt lgkmcnt(0)" ::: "memory");
        }
    }
    if ((mode & 16) && l + 1 < NLAYER) gen_w16(p, ws, l + 1, bid * NTHR + tid, G * NTHR);
}

#define XB_TMO      128
#define XB_XCNT(j)  (256  + 64 * (j))
#define XB_XSUB(j)  (1280 + 64 * (j))
#define XB_XGEN(j)  (2304 + 64 * (j))
#define XB_TOP      3328
#define XB_TOPGEN   3392
#define XCD_BAR_WORDS 3456
#define XB_SPIN_CAP (1u << 18)

__device__ __forceinline__ unsigned xb_ld(unsigned* p)              { return __hip_atomic_load(p, __ATOMIC_RELAXED, __HIP_MEMORY_SCOPE_AGENT); }
__device__ __forceinline__ unsigned xb_add(unsigned* p, unsigned v) { return __hip_atomic_fetch_add(p, v, __ATOMIC_RELAXED, __HIP_MEMORY_SCOPE_AGENT); }
__device__ __forceinline__ unsigned xb_xcc_id() { return (unsigned)__builtin_amdgcn_s_getreg((3 << 11) | 20) & 0xFu; }
#define XB_SPIN(cond, bar) do { unsigned _sp = 0; while (cond) { __builtin_amdgcn_s_sleep(1); \
    if ((++_sp & 255u) == 0u) { if (xb_ld(&(bar)[XB_TMO])) break; if (_sp > XB_SPIN_CAP) { atomicAdd(&(bar)[XB_TMO], 1u); break; } } } } while (0)

struct XcdBarrier {
    unsigned* bar; unsigned x;
    volatile LAS unsigned* st;
};

__device__ __forceinline__ XcdBarrier xcd_barrier_post(unsigned* bar, volatile LAS unsigned* st) {
    XcdBarrier b; b.bar = bar; b.x = xb_xcc_id(); b.st = st;
    if (threadIdx.x == 0) (void)xb_add(&bar[XB_XCNT(b.x)], 1u);
    return b;
}
__device__ __forceinline__ void xcd_barrier_complete(unsigned* bar, unsigned x, unsigned& nloc, unsigned& nx) {
    const unsigned G = gridDim.x * gridDim.y * gridDim.z;
    unsigned sum, cnt, mine, sp = 0u;
    for (;;) {
        sum = 0u; cnt = 0u; mine = 0u;
#pragma unroll
        for (unsigned j = 0; j < 16; ++j) { const unsigned c = xb_ld(&bar[XB_XCNT(j)]); sum += c; cnt += (c > 0u) ? 1u : 0u; mine = (j == x) ? c : mine; }
        if (sum == G) break;
        __builtin_amdgcn_s_sleep(1);
        if ((++sp & 255u) == 0u) { if (xb_ld(&bar[XB_TMO])) break; if (sp > XB_SPIN_CAP) { atomicAdd(&bar[XB_TMO], 1u); break; } }
    }
    nloc = mine > 0u ? mine : 1u; nx = cnt > 0u ? cnt : 1u;
}

__device__ __forceinline__ void xcd_barrier(const XcdBarrier& b) {
    asm volatile("s_waitcnt vmcnt(0)" ::: "memory");
    __syncthreads();
    if (threadIdx.x == 0) {
        unsigned* bar = b.bar;
        __builtin_amdgcn_s_waitcnt(0);
        unsigned nloc = b.st[0], nx = b.st[1];
        if (nloc == 0u) { xcd_barrier_complete(bar, b.x, nloc, nx); b.st[0] = nloc; b.st[1] = nx; }
        const unsigned old = xb_add(&bar[XB_XSUB(b.x)], 1u);
        const unsigned gen = old / nloc;
        if (old + 1u == (gen + 1u) * nloc) {
            __builtin_amdgcn_fence(__ATOMIC_RELEASE, "agent");
            asm volatile("s_waitcnt vmcnt(0)" ::: "memory");
            const unsigned og = xb_add(&bar[XB_TOP], 1u);
            const unsigned tg = og / nx;
            if (og + 1u == (tg + 1u) * nx) xb_add(&bar[XB_TOPGEN], 1u);
            else XB_SPIN(xb_ld(&bar[XB_TOPGEN]) == tg, bar);
            __builtin_amdgcn_fence(__ATOMIC_ACQUIRE, "agent");
            xb_add(&bar[XB_XGEN(b.x)], 1u);
            asm volatile("s_waitcnt vmcnt(0)" ::: "memory");
        } else {
            XB_SPIN(xb_ld(&bar[XB_XGEN(b.x)]) == gen, bar);
            __builtin_amdgcn_fence(__ATOMIC_ACQUIRE, "agent");
            asm volatile("s_waitcnt vmcnt(0)" ::: "memory");
        }
    }
    __syncthreads();
}

#ifndef PHM
#define PHM 127
#endif
#ifndef DUP
#define DUP 0
#endif
__global__ void __launch_bounds__(NTHR, 2) hpge_fwd(Params p) {
    extern __shared__ __attribute__((aligned(16))) unsigned char lds_raw[];
    LAS unsigned char* lds = (LAS unsigned char*)lds_raw;
    const int tid = threadIdx.x, lane = tid & 63, wave = __builtin_amdgcn_readfirstlane(tid >> 6);
    const int bid = blockIdx.x, G = gridDim.x;
    unsigned char* ws = p.ws;
    const int lo = p.ph_lo, hi = p.ph_hi;
    const bool coop = (hi - lo) > 1;
#define IN(k) (lo <= (k) && (k) < hi)
    volatile LAS unsigned* MISC = (volatile LAS unsigned*)(lds + LDS_BYTES - 64);
    if (tid < 16) MISC[tid] = 0u;
    __syncthreads();
    XcdBarrier bar; bar.bar = (unsigned*)ws; bar.x = 0; bar.st = nullptr;
    if (coop) bar = xcd_barrier_post((unsigned*)ws, MISC);
    if (hi > NPHASE) { __threadfence(); cg::this_grid().sync(); }
#define SEAM(k) do { if (coop && IN(k) && IN((k) + 1)) { xcd_barrier(bar); if (DUP & 1) xcd_barrier(bar); } } while (0)
    if (IN(0) && (PHM & 1)) { phase_p0a(p, lds, bid, G, tid, lane, wave); if (DUP & 2) { __syncthreads(); phase_p0a(p, lds, bid, G, tid, lane, wave); } }
    SEAM(0);
    if (IN(1) && (PHM & 2)) { phase_p0b(p, lds, bid, G, tid, lane, wave); if (DUP & 512) { __syncthreads(); phase_p0b(p, lds, bid, G, tid, lane, wave); } }
    SEAM(1);
#pragma unroll 1
    for (int l = 0; l < NLAYER; ++l) {
        const int pb = 2 + 4 * l;
        if (IN(pb) && (PHM & 4)) {
            __syncthreads();
            pg8::Gemm g{(const bf16_t*)(ws + WS_X16), (const bf16_t*)(ws + WS_W16), MTOK, NIN, D, D, D, 0xE00u, (size_t)NIN * D * 2};
            pg8::StaticOrder S; S.init(MTOK, NIN, G, bid);
            Epi1 E{(bf16_t*)(ws + WS_Z), (u16*)(ws + WS_ZT), (const float*)(ws + WS_SSQ), (const float*)(ws + WS_SB) + (size_t)l * NB * NIN, 0};
            if (DUP & 4) { E.noact = 2; pg8::gemm_phase<Epi1, pg8::StaticOrder, true, true, true>(lds, g, S, E); E.noact = 0; __syncthreads(); xcd_barrier(bar); }
            pg8::gemm_phase<Epi1, pg8::StaticOrder, true, true, true>(lds, g, S, E);
        }
        SEAM(pb);
        if (IN(pb + 1) && (PHM & 8)) { phase_p2a(p, lds, bid, G, tid, lane, wave); if (DUP & 8) phase_p2a(p, lds, bid, G, tid, lane, wave, 1); if (DUP & 16) phase_p2a(p, lds, bid, G, tid, lane, wave, 6); }
        SEAM(pb + 1);
        if (IN(pb + 2) && (PHM & 16)) { phase_p2b(p, lds, l, bid, G, tid, lane, wave); if (DUP & 32) phase_p2b(p, lds, l, bid, G, tid, lane, wave, 9); if (DUP & 64) phase_p2b(p, lds, l, bid, G, tid, lane, wave, 10); if (DUP & 128) phase_p2b(p, lds, l, bid, G, tid, lane, wave, 12); }
        SEAM(pb + 2);
        if (IN(pb + 3) && (PHM & 32)) {
            __syncthreads();
            pg8::Gemm g{(const bf16_t*)(ws + WS_Z), (const bf16_t*)(ws + WS_WOUT) + (size_t)l * D * D, MTOK, D, D, ZW, D, 0u, 0};
            pg8::StaticOrder S; S.init(MTOK, D, G, bid);
            Epi2 E{(u16*)(ws + WS_X16), (float*)(ws + WS_SSQ), (const float*)(ws + WS_MOD) + (size_t)l * NB * 3072 + 2048, 1.f};
            if (DUP & 1024) { E.gscale = 0.f; E.ssq = (float*)(ws + WS_END); pg8::gemm_phase<Epi2, pg8::StaticOrder, true, true>(lds, g, S, E); E.gscale = 1.f; E.ssq = (float*)(ws + WS_SSQ); __syncthreads(); }
            pg8::gemm_phase<Epi2, pg8::StaticOrder, true, true>(lds, g, S, E);
            if (l + 1 < NLAYER) gen_w16(p, ws, l + 1, bid * NTHR + tid, G * NTHR);
        }
        SEAM(pb + 3);
    }
    if (IN(NPHASE - 1) && (PHM & 64)) { phase_final(p, bid, G, lane, wave); }
#undef IN
#undef SEAM
}

#ifndef HPGE_MULTI
#define HPGE_MULTI 0
#endif
extern "C" void kernel_launch(void* const* d_in, const int* in_sizes, int n_in, void* d_out, int out_size, void* d_ws, size_t ws_size, hipStream_t stream) {
    static int grid = 0;
    if (grid == 0) {
        if (n_in != 17 || out_size != MTOK * D || ws_size < WS_END) { fprintf(stderr, "kernel_launch: unexpected shapes (n_in %d out %d ws %zu)\n", n_in, out_size, ws_size); grid = -1; return; }
        int dev = 0, cus = 0, per_cu = 0;
        (void)hipGetDevice(&dev); (void)hipDeviceGetAttribute(&cus, hipDeviceAttributeMultiprocessorCount, dev);
        if (hipFuncSetAttribute((const void*)hpge_fwd, hipFuncAttributeMaxDynamicSharedMemorySize, LDS_BYTES) != hipSuccess) { fprintf(stderr, "kernel_launch: hipFuncSetAttribute failed\n"); grid = -1; return; }
        if (hipOccupancyMaxActiveBlocksPerMultiprocessor(&per_cu, (const void*)hpge_fwd, NTHR, LDS_BYTES) != hipSuccess || per_cu < 1) { fprintf(stderr, "kernel_launch: occupancy query gave %d\n", per_cu); per_cu = 1; }
        (void)hipGetLastError();
        grid = cus * (per_cu > 1 ? 1 : per_cu);
        if (grid <= 0) grid = 256;
    }
    if (grid < 0) return;
    if (hipMemsetAsync(d_ws, 0, 16384, stream) != hipSuccess) { fprintf(stderr, "kernel_launch: memset failed\n"); return; }
    Params p{};
    for (int i = 0; i < 17; ++i) p.in[i] = (const float*)d_in[i];
    p.out = (float*)d_out; p.ws = (unsigned char*)d_ws;
#if HPGE_MULTI
    for (int k = 0; k < NPHASE; ++k) { p.ph_lo = k; p.ph_hi = k + 1; hipLaunchKernelGGL(hpge_fwd, dim3(grid), dim3(NTHR), LDS_BYTES, stream, p); }
#else
    p.ph_lo = 0; p.ph_hi = NPHASE;
    void* args[] = {&p};
    const hipError_t e = hipLaunchCooperativeKernel((const void*)hpge_fwd, dim3(grid), dim3(NTHR), args, LDS_BYTES, stream);
    if (e != hipSuccess) fprintf(stderr, "kernel_launch: cooperative launch failed: %s (grid %d)\n", hipGetErrorString(e), grid);
#endif
}
```
